# Optimizing an MI355X kernel written in HIP

```python
import jax, jax.numpy as jnp
from jax import lax
import numpy as np

D_MODEL = 1024
BATCH = 4
SEQ = 8192
DEPTH = 4

D_MIX = D_MODEL
D_CONF = D_MIX // 4
D_ATT = D_MIX // 4
D_SC = D_MIX // 4
D_POOL = D_MIX - D_CONF - D_ATT - D_SC
HEAD_DIM = 64
N_ATT_HEADS = D_ATT // HEAD_DIM
CONF_KERNEL = 31
SC_KERNEL = 3
POOL_WINDOWS = (2, 4, 8, 16)
N_POOL_GROUPS = len(POOL_WINDOWS)
POOL_GROUP_DIM = D_POOL // N_POOL_GROUPS
D_FF = 4 * D_MODEL
D_PLE = 256
Q_BLOCK = 128
EPS = 1e-6
SPLITS = (2 * D_CONF, D_ATT, D_ATT, D_ATT, N_ATT_HEADS, D_SC, D_SC, D_SC, D_POOL)
D_IN = sum(SPLITS)
SPLIT_IDX = tuple(int(s) for s in np.cumsum(SPLITS)[:-1])

kernel_name = "hybrid_parallel_groups_fox_conv_pool"


def rms_norm(x, g):
    x32 = x.astype(jnp.float32)
    y = x32 * lax.rsqrt(jnp.mean(x32 * x32, axis=-1, keepdims=True) + EPS)
    return (y * g.astype(jnp.float32)).astype(x.dtype)


def layer_norm(x, g, b):
    x32 = x.astype(jnp.float32)
    mu = jnp.mean(x32, axis=-1, keepdims=True)
    xc = x32 - mu
    y = xc * lax.rsqrt(jnp.mean(xc * xc, axis=-1, keepdims=True) + EPS)
    return (y * g.astype(jnp.float32) + b.astype(jnp.float32)).astype(x.dtype)


def causal_depthwise_conv(u, w):
    k = w.shape[0]
    return lax.conv_general_dilated(
        u, w[:, None, :].astype(u.dtype), window_strides=(1,), padding=((k - 1, 0),),
        dimension_numbers=("NWC", "WIO", "NWC"), feature_group_count=u.shape[-1])


def conformer_conv(ab, w_dw, ln_g, ln_b, w_pw):
    a, b = jnp.split(ab, 2, axis=-1)
    u = a * jax.nn.sigmoid(b)
    u = causal_depthwise_conv(u, w_dw)
    u = jax.nn.silu(layer_norm(u, ln_g, ln_b))
    return u @ w_pw


def forgetting_attention(q, k, v, f_logit):
    b, s, _ = q.shape
    q = q.reshape(b, s, N_ATT_HEADS, HEAD_DIM).transpose(0, 2, 1, 3)
    k = k.reshape(b, s, N_ATT_HEADS, HEAD_DIM).transpose(0, 2, 1, 3)
    v = v.reshape(b, s, N_ATT_HEADS, HEAD_DIM).transpose(0, 2, 1, 3)
    log_f = jax.nn.log_sigmoid(f_logit.astype(jnp.float32))
    c = jnp.cumsum(log_f, axis=1).transpose(0, 2, 1)
    nb = s // Q_BLOCK
    qb = q.reshape(b, N_ATT_HEADS, nb, Q_BLOCK, HEAD_DIM).transpose(2, 0, 1, 3, 4)
    cb = c.reshape(b, N_ATT_HEADS, nb, Q_BLOCK).transpose(2, 0, 1, 3)
    pos = jnp.arange(s, dtype=jnp.int32)
    posb = pos.reshape(nb, Q_BLOCK)
    k32 = k.astype(jnp.float32)
    scale = HEAD_DIM ** -0.5

    def block(args):
        qi, ci, pi = args
        logits = jnp.einsum("bhqd,bhkd->bhqk", qi.astype(jnp.float32), k32) * scale
        logits = logits + ci[..., None] - c[:, :, None, :]
        mask = pi[:, None] >= pos[None, :]
        logits = jnp.where(mask, logits, -jnp.inf)
        probs = jax.nn.softmax(logits, axis=-1)
        return jnp.einsum("bhqk,bhkd->bhqd", probs.astype(v.dtype), v)

    o = lax.map(block, (qb, cb, posb))
    return o.transpose(1, 0, 3, 2, 4).reshape(b, s, D_ATT)


def short_conv_mixer(h, bg, cg, w_sc):
    return bg * causal_depthwise_conv(cg * h, w_sc)


def multiscale_pool(v, w_pool, scale):
    b, s, _ = v.shape
    v32 = v.astype(jnp.float32)
    count = jnp.arange(1, s + 1, dtype=jnp.float32)[None, :, None]
    groups = jnp.split(v32, N_POOL_GROUPS, axis=-1)
    outs = []
    for g, w in zip(groups, POOL_WINDOWS):
        csum = jnp.cumsum(g, axis=1)
        lag = jnp.pad(csum, ((0, 0), (w, 0), (0, 0)))[:, :s]
        mean = (csum - lag) / jnp.minimum(count, w)
        outs.append(mean - g)
    d = jnp.stack(outs, axis=2).astype(v.dtype)
    d = jnp.einsum("bsgc,gcd->bsgd", d, w_pool).reshape(b, s, D_POOL)
    return d * scale


def setup_inputs(seed: int = 0) -> dict:
    key = jax.random.key(seed)
    ks = jax.random.split(key, 24)
    f32 = jnp.float32
    L = DEPTH

    def nrm(k, shape, fan_in):
        return jax.random.normal(k, shape, f32) * (fan_in ** -0.5)

    def gain(k, shape):
        return 1.0 + 0.05 * jax.random.normal(k, shape, f32)

    return {
        "x": jax.random.normal(ks[0], (BATCH, SEQ, D_MODEL), f32),
        "p": jax.random.normal(ks[1], (DEPTH, BATCH, SEQ, D_PLE), f32),
        "g_mix_pre": gain(ks[2], (L, D_MODEL)),
        "w_in": nrm(ks[3], (L, D_MODEL, D_IN), D_MODEL),
        "b_forget": 0.1 * jax.random.normal(ks[4], (L, N_ATT_HEADS), f32),
        "w_conf_dw": nrm(ks[5], (L, CONF_KERNEL, D_CONF), CONF_KERNEL),
        "conf_ln_g": gain(ks[6], (L, D_CONF)),
        "conf_ln_b": 0.02 * jax.random.normal(ks[7], (L, D_CONF), f32),
        "w_conf_pw": nrm(ks[8], (L, D_CONF, D_CONF), D_CONF),
        "w_sc": nrm(ks[9], (L, SC_KERNEL, D_SC), SC_KERNEL),
        "w_pool": nrm(ks[10], (L, N_POOL_GROUPS, POOL_GROUP_DIM, POOL_GROUP_DIM), POOL_GROUP_DIM),
        "pool_scale": gain(ks[11], (L, D_POOL)),
        "w_out": nrm(ks[12], (L, D_MIX, D_MODEL), D_MIX),
        "g_mix_post": gain(ks[13], (L, D_MODEL)),
        "g_mlp_pre": gain(ks[14], (L, D_MODEL)),
        "w_up": nrm(ks[15], (L, D_MODEL, D_FF), D_MODEL),
        "w_down": nrm(ks[16], (L, D_FF, D_MODEL), D_FF),
        "g_mlp_post": gain(ks[17], (L, D_MODEL)),
        "g_ple_pre": gain(ks[18], (L, D_MODEL)),
        "w_ple_gate": nrm(ks[19], (L, D_MODEL, D_MODEL), D_MODEL),
        "w_ple_proj": nrm(ks[20], (L, D_PLE, D_MODEL), D_PLE),
        "g_ple_post": gain(ks[21], (L, D_MODEL)),
    }


def reference(x, p, g_mix_pre, w_in, b_forget, w_conf_dw, conf_ln_g, conf_ln_b, w_conf_pw,
              w_sc, w_pool, pool_scale, w_out, g_mix_post, g_mlp_pre, w_up, w_down,
              g_mlp_post, g_ple_pre, w_ple_gate, w_ple_proj, g_ple_post):
    h = x
    for i in range(DEPTH):
        xn = rms_norm(h, g_mix_pre[i])
        z = xn @ w_in[i]
        conf_ab, q, k, v, f_logit, sc_h, sc_b, sc_c, pool_v = jnp.split(z, SPLIT_IDX, axis=-1)
        y_conf = conformer_conv(conf_ab, w_conf_dw[i], conf_ln_g[i], conf_ln_b[i], w_conf_pw[i])
        y_att = forgetting_attention(q, k, v, f_logit + b_forget[i])
        y_sc = short_conv_mixer(sc_h, sc_b, sc_c, w_sc[i])
        y_pool = multiscale_pool(pool_v, w_pool[i], pool_scale[i])
        mix = jnp.concatenate([y_conf, y_att, y_sc, y_pool], axis=-1) @ w_out[i]
        h = h + rms_norm(mix, g_mix_post[i])
        hn = rms_norm(h, g_mlp_pre[i])
        ff = jnp.square(jax.nn.relu(hn @ w_up[i])) @ w_down[i]
        h = h + rms_norm(ff, g_mlp_post[i])
        gate = jax.nn.sigmoid(rms_norm(h, g_ple_pre[i]) @ w_ple_gate[i])
        e = (p[i] @ w_ple_proj[i]) * gate
        h = h + rms_norm(e, g_ple_post[i])
    return h
```

```cpp
#include <hip/hip_runtime.h>
#include <hip/hip_cooperative_groups.h>
#include <hip/hip_bf16.h>
#include <cstdio>
#include <cstdint>
#include <cmath>
namespace pg8 {
#define PG8_LAS __attribute__((address_space(3)))
typedef unsigned short bf16_t;
typedef short bf16x8 __attribute__((ext_vector_type(8)));
typedef float f32x4 __attribute__((ext_vector_type(4)));
typedef unsigned u32x4 __attribute__((ext_vector_type(4)));
constexpr int BM = 256, BK = 64, HALF = 128, HTB = HALF * BK * 2  , STAGE_BYTES = 8 * HTB, NXCD = 8, WGM = 4;

__host__ __device__ __forceinline__ int lds_byte(int r, int c) { const int st = (r >> 4) * 2 + (c >> 5), rr = r & 15, cc = c & 31, ob = rr * 64 + cc * 2; return st * 1024 + (ob ^ (((ob >> 9) & 1) << 5)); }
__host__ __device__ __forceinline__ void stage_rc(int b, int& R, int& C) { const int st = b / 1024, sb = b % 1024, swz = sb ^ (((sb >> 9) & 1) << 5); R = (st >> 1) * 16 + swz / 64; C = (st & 1) * 32 + (swz % 64) / 2; }
__host__ __device__ __forceinline__ int perm32(int rho) { const int n = rho >> 4, i = rho & 15; return 8 * (i >> 2) + 4 * n + (i & 3); }

struct Unit { int pm, pn; };
struct Gemm { const bf16_t* A; const bf16_t* Bt; int M, N, K; };

struct StaticOrder {
    int nM, nN, nwg, G, c;
    __host__ __device__ void init(int M, int N, int G_, int c_) { nM = M / BM; nN = N / BM; nwg = nM * nN; G = G_; c = c_; }
    __host__ __device__ bool next(int i, Unit& u) const {
        const long L = (long)i * G + c; if (L >= nwg) return false;
        int wgid = (int)L; { const int q = nwg / NXCD, r = nwg % NXCD, xcd = wgid % NXCD, off = wgid / NXCD; wgid = (xcd < r ? xcd * (q + 1) : r * (q + 1) + (xcd - r) * q) + off; }
        const int nig = WGM * nN, gid = wgid / nig, fm = gid * WGM, gsz = (nM - fm) < WGM ? (nM - fm) : WGM;
        u.pm = fm + ((wgid % nig) % gsz); u.pn = (wgid % nig) / gsz; return true;
    }
    __device__ __forceinline__ void a_ready(const Unit&) const {}
    __device__ __forceinline__ void done(const Unit&) const {}
};

__device__ __forceinline__ unsigned cvt_pk_bf16(float lo, float hi) { unsigned r; asm volatile("v_cvt_pk_bf16_f32 %0, %1, %2" : "=v"(r) : "v"(lo), "v"(hi)); return r; }
__device__ __forceinline__ float bf_lo(unsigned w) { return __uint_as_float(w << 16); }
__device__ __forceinline__ float bf_hi(unsigned w) { return __uint_as_float(w & 0xffff0000u); }
__device__ __forceinline__ float sigmoid_f(float x) { return __builtin_amdgcn_rcpf(1.0f + __builtin_amdgcn_exp2f(-1.4426950408889634f * x)); }
template <int MODE> struct EpiT {
    static constexpr bool PERM = true, AFTER_DRAIN = false;
    bf16_t* O; int ldc; const bf16_t* P; int qtile; float qscale; float* NRM; const float* RS;
    __device__ __forceinline__ void operator()(const f32x4 (&acc)[2][2][4][2], const Unit& u, int wr, int wc, int fr, int fq) const {
        const int row0 = u.pm * BM + wr * 64 + fr; const int col0 = u.pn * BM + wc * 32 + 8 * fq;
        const float sc = (MODE == 2 && u.pn == qtile) ? qscale : 1.f;
#pragma unroll
        for (int ai = 0; ai < 2; ++ai)
#pragma unroll
            for (int m = 0; m < 4; ++m) { const size_t off = (size_t)(row0 + ai * HALF + m * 16) * ldc + col0; const float rs = (MODE != 0) ? RS[row0 + ai * HALF + m * 16] : 1.f;
#pragma unroll
                for (int bj = 0; bj < 2; ++bj) { f32x4 v0 = acc[ai][bj][m][0], v1 = acc[ai][bj][m][1];
                    if (MODE != 0) { v0 = v0 * rs; v1 = v1 * rs; }
                    if (MODE == 1) {
#pragma unroll
                        for (int e = 0; e < 4; ++e) { const float a = fmaxf(v0[e], 0.f), b = fmaxf(v1[e], 0.f); v0[e] = a * a; v1[e] = b * b; } }
                    if (MODE == 2) { v0 = v0 * sc; v1 = v1 * sc; }
                    if (MODE == 3) { const u32x4 pw = *(const u32x4*)(P + off + bj * HALF);
                        v0[0] = bf_lo(pw.x) * sigmoid_f(v0[0]); v0[1] = bf_hi(pw.x) * sigmoid_f(v0[1]); v0[2] = bf_lo(pw.y) * sigmoid_f(v0[2]); v0[3] = bf_hi(pw.y) * sigmoid_f(v0[3]);
                        v1[0] = bf_lo(pw.z) * sigmoid_f(v1[0]); v1[1] = bf_hi(pw.z) * sigmoid_f(v1[1]); v1[2] = bf_lo(pw.w) * sigmoid_f(v1[2]); v1[3] = bf_hi(pw.w) * sigmoid_f(v1[3]); }
                    u32x4 w; w.x = cvt_pk_bf16(v0[0], v0[1]); w.y = cvt_pk_bf16(v0[2], v0[3]); w.z = cvt_pk_bf16(v1[0], v1[1]); w.w = cvt_pk_bf16(v1[2], v1[3]);
                    *(u32x4*)(O + off + bj * HALF) = w; } }
        if (MODE == 2) { if (u.pn == qtile || u.pn == qtile + 1) {
#pragma unroll
            for (int ai = 0; ai < 2; ++ai)
#pragma unroll
                for (int bj = 0; bj < 2; ++bj) { float mx = 0.f;
#pragma unroll
                    for (int m = 0; m < 4; ++m) { const float rs = RS[row0 + ai * HALF + m * 16] * sc; const f32x4 v0 = acc[ai][bj][m][0] * rs, v1 = acc[ai][bj][m][1] * rs;
                        float ss = ((v0[0] * v0[0] + v0[1] * v0[1]) + (v0[2] * v0[2] + v0[3] * v0[3])) + ((v1[0] * v1[0] + v1[1] * v1[1]) + (v1[2] * v1[2] + v1[3] * v1[3]));
                        ss += __shfl_xor(ss, 16); ss += __shfl_xor(ss, 32); mx = fmaxf(mx, ss); }
                    mx = fmaxf(mx, __shfl_xor(mx, 1)); mx = fmaxf(mx, __shfl_xor(mx, 2)); mx = fmaxf(mx, __shfl_xor(mx, 4)); mx = fmaxf(mx, __shfl_xor(mx, 8));
                    if (fr == 0 && fq == 0) NRM[(((u.pn - qtile) * 2 + (wc & 1)) * 512 + (u.pm * 4 + ai * 2 + wr)) * 4 + bj * 2 + (wc >> 1)] = mx; } } }
    }
};

template <class Epi, class Sched, bool ALIGN_EPI = false, bool SP2 = false>
__device__ __forceinline__ void gemm_phase(PG8_LAS unsigned char* lds, const Gemm g, const Sched& S, const Epi& E, int tid_in) {
    int tid_raw_ = tid_in; asm volatile("" : "+v"(tid_raw_));
    const int tid = tid_raw_, wid = __builtin_amdgcn_readfirstlane(tid >> 6), lane = tid & 63, wr = wid >> 2, wc = wid & 3, fr = lane & 15, fq = lane >> 4;
    const int K = g.K, nt = K / BK;
    unsigned voffA[2], voffB[2];
#pragma unroll
    for (int i = 0; i < 2; ++i) { int R, C; stage_rc(tid * 16 + i * 8192, R, C); const int Rb = Epi::PERM ? ((R & ~31) + perm32(R & 31)) : R;
        voffA[i] = (unsigned)(R * K + C) * 2u; voffB[i] = (unsigned)(Rb * K + C) * 2u; }
    const size_t kstep = (size_t)(BK * 2);
    const size_t hstep = (size_t)HALF * K * 2;
    const size_t tstep = 2 * hstep;
    const unsigned ldsw = (unsigned)wid * 1024u;
    const int aoff = lds_byte(wr * 64 + fr, fq * 8), boff = lds_byte(wc * 32 + fr, fq * 8);
#define PG8_SA(b, h) (((b) * 2 + (h)) * HTB)
#define PG8_SB(b, h) ((4 + (b) * 2 + (h)) * HTB)
#define PG8_STAGE(bufoff, gbase, voff) do { _Pragma("unroll") for (int _i = 0; _i < 2; ++_i) \
        __builtin_amdgcn_global_load_lds((const unsigned*)((const char*)(gbase) + (voff)[_i]), (PG8_LAS unsigned*)(lds + (bufoff) + ldsw + _i * 8192), 16, 0, 0); } while (0)
#define PG8_LDA(dst, b, h) do { _Pragma("unroll") for (int m = 0; m < 4; ++m) _Pragma("unroll") for (int k = 0; k < 2; ++k) dst[m][k] = *(const PG8_LAS bf16x8*)(lds + PG8_SA(b, h) + aoff + m * 2048 + k * 1024); } while (0)
#define PG8_LDB(dst, b, h) do { _Pragma("unroll") for (int n = 0; n < 2; ++n) _Pragma("unroll") for (int k = 0; k < 2; ++k) dst[n][k] = *(const PG8_LAS bf16x8*)(lds + PG8_SB(b, h) + boff + n * 2048 + k * 1024); } while (0)
#define PG8_MMA(ai, bj, At, Bt) do { __builtin_amdgcn_s_setprio(1); _Pragma("unroll") for (int m = 0; m < 4; ++m) _Pragma("unroll") for (int n = 0; n < 2; ++n) _Pragma("unroll") for (int k = 0; k < 2; ++k) \
        acc[ai][bj][m][n] = __builtin_amdgcn_mfma_f32_16x16x32_bf16(Bt[n][k], At[m][k], acc[ai][bj][m][n], 0, 0, 0); __builtin_amdgcn_s_setprio(0); } while (0)
#define PG8_WAIT_V(n) asm volatile("s_waitcnt vmcnt(" #n ")" ::: "memory")
#define PG8_WAIT_L(n) asm volatile("s_waitcnt lgkmcnt(" #n ")" ::: "memory")
#define PG8_BAR __builtin_amdgcn_s_barrier()
#define PG8_SCHED __builtin_amdgcn_sched_barrier(0)
    Unit cur, nxt; int ui = 0;
    if (!S.next(0, cur)) return;
    f32x4 acc[2][2][4][2];
#pragma unroll
    for (int a = 0; a < 2; ++a)
#pragma unroll
        for (int b = 0; b < 2; ++b)
#pragma unroll
            for (int m = 0; m < 4; ++m)
#pragma unroll
                for (int n = 0; n < 2; ++n) acc[a][b][m][n] = (f32x4){0.f, 0.f, 0.f, 0.f};
    bf16x8 At[4][2], B0[2][2], B1[2][2];
    const char* cA = (const char*)g.A + (size_t)cur.pm * tstep; const char* cB = (const char*)g.Bt + (size_t)cur.pn * tstep;
    S.a_ready(cur);
    if constexpr (SP2) {
        PG8_STAGE(PG8_SB(0, 0), cB, voffB); PG8_STAGE(PG8_SB(0, 1), cB + hstep, voffB); PG8_STAGE(PG8_SA(0, 0), cA, voffA); PG8_STAGE(PG8_SA(0, 1), cA + hstep, voffA);
        if (wr == 1) PG8_BAR;
        PG8_WAIT_V(2); PG8_BAR;
        PG8_STAGE(PG8_SB(1, 0), cB + kstep, voffB); PG8_STAGE(PG8_SA(1, 0), cA + kstep, voffA); PG8_STAGE(PG8_SB(1, 1), cB + hstep + kstep, voffB);
        PG8_WAIT_V(6); PG8_BAR;
    } else {
        PG8_STAGE(PG8_SB(0, 0), cB, voffB); PG8_STAGE(PG8_SA(0, 0), cA, voffA); PG8_STAGE(PG8_SB(0, 1), cB + hstep, voffB); PG8_STAGE(PG8_SA(0, 1), cA + hstep, voffA);
        if (wr == 1) PG8_BAR;
        PG8_WAIT_V(4); PG8_BAR;
        PG8_STAGE(PG8_SB(1, 0), cB + kstep, voffB); PG8_STAGE(PG8_SA(1, 0), cA + kstep, voffA); PG8_STAGE(PG8_SB(1, 1), cB + hstep + kstep, voffB);
        PG8_WAIT_V(6); PG8_BAR;
    }
    for (;;) {
        const bool has_next = S.next(ui + 1, nxt);
        const char* nA = has_next ? (const char*)g.A + (size_t)nxt.pm * tstep : cA; const char* nB = has_next ? (const char*)g.Bt + (size_t)nxt.pn * tstep : cB;
        for (int t = 0; t < nt; t += 2) {
            const bool last = (t == nt - 2);
            const char* a1 = cA + (size_t)(t + 1) * kstep;
            const char* a2 = last ? nA : cA + (size_t)(t + 2) * kstep; const char* b2 = last ? nB : cB + (size_t)(t + 2) * kstep;
            const char* a3 = a2 + kstep; const char* b3 = b2 + kstep;
            if (last && has_next) S.a_ready(nxt);
            if constexpr (SP2) {
            PG8_LDB(B0, 0, 0); PG8_LDB(B1, 0, 1); PG8_SCHED; PG8_LDA(At, 0, 0); PG8_STAGE(PG8_SA(1, 1), a1 + hstep, voffA);
            PG8_WAIT_V(8); PG8_WAIT_L(0); PG8_BAR; PG8_MMA(0, 0, At, B0); PG8_MMA(0, 1, At, B1); PG8_BAR; PG8_SCHED;
            PG8_LDA(At, 0, 1); PG8_STAGE(PG8_SB(0, 0), b2, voffB); PG8_STAGE(PG8_SB(0, 1), b2 + hstep, voffB); PG8_STAGE(PG8_SA(0, 0), a2, voffA);
            PG8_WAIT_V(8); PG8_WAIT_L(0); PG8_BAR; PG8_MMA(1, 0, At, B0); PG8_MMA(1, 1, At, B1); PG8_BAR; PG8_SCHED;
            PG8_LDB(B0, 1, 0); PG8_LDB(B1, 1, 1); PG8_SCHED; PG8_LDA(At, 1, 0); PG8_STAGE(PG8_SA(0, 1), a2 + hstep, voffA);
            PG8_WAIT_V(8); PG8_WAIT_L(0); PG8_BAR; PG8_MMA(0, 0, At, B0); PG8_MMA(0, 1, At, B1); PG8_BAR; PG8_SCHED;
            PG8_LDA(At, 1, 1); PG8_STAGE(PG8_SB(1, 0), b3, voffB); PG8_STAGE(PG8_SB(1, 1), b3 + hstep, voffB); PG8_STAGE(PG8_SA(1, 0), a3, voffA);
            PG8_WAIT_V(8); PG8_WAIT_L(0); PG8_BAR; PG8_MMA(1, 0, At, B0); PG8_MMA(1, 1, At, B1); PG8_BAR; PG8_SCHED;
            } else {
            PG8_LDB(B0, 0, 0); PG8_SCHED; PG8_LDA(At, 0, 0); PG8_STAGE(PG8_SA(1, 1), a1 + hstep, voffA);
            PG8_WAIT_L(8); PG8_BAR; PG8_WAIT_L(0); PG8_MMA(0, 0, At, B0); PG8_BAR; PG8_SCHED;
            PG8_LDB(B1, 0, 1); PG8_STAGE(PG8_SB(0, 0), b2, voffB);
            PG8_BAR; PG8_WAIT_L(0); PG8_MMA(0, 1, At, B1); PG8_BAR;
            PG8_LDA(At, 0, 1); PG8_STAGE(PG8_SA(0, 0), a2, voffA);
            PG8_BAR; PG8_WAIT_L(0); PG8_MMA(1, 0, At, B0); PG8_BAR; PG8_SCHED;
            PG8_STAGE(PG8_SB(0, 1), b2 + hstep, voffB);
            PG8_WAIT_V(6); PG8_BAR; PG8_MMA(1, 1, At, B1); PG8_BAR;
            PG8_LDB(B0, 1, 0); PG8_SCHED; PG8_LDA(At, 1, 0); PG8_STAGE(PG8_SA(0, 1), a2 + hstep, voffA);
            PG8_WAIT_L(8); PG8_BAR; PG8_WAIT_L(0); PG8_MMA(0, 0, At, B0); PG8_BAR; PG8_SCHED;
            PG8_LDB(B1, 1, 1); PG8_STAGE(PG8_SB(1, 0), b3, voffB);
            PG8_BAR; PG8_WAIT_L(0); PG8_MMA(0, 1, At, B1); PG8_BAR;
            PG8_LDA(At, 1, 1); PG8_STAGE(PG8_SA(1, 0), a3, voffA);
            PG8_BAR; PG8_WAIT_L(0); PG8_MMA(1, 0, At, B0); PG8_BAR; PG8_SCHED;
            PG8_STAGE(PG8_SB(1, 1), b3 + hstep, voffB);
            PG8_WAIT_V(6); PG8_BAR; PG8_MMA(1, 1, At, B1); PG8_BAR;
            }
        }
        if constexpr (ALIGN_EPI) { if (wr == 0) PG8_BAR; }
        if constexpr (!Epi::AFTER_DRAIN) { E(acc, cur, wr, wc, fr, fq); S.done(cur); }
        if (!has_next) break;
#pragma unroll
        for (int a = 0; a < 2; ++a)
#pragma unroll
            for (int b = 0; b < 2; ++b)
#pragma unroll
                for (int m = 0; m < 4; ++m)
#pragma unroll
                    for (int n = 0; n < 2; ++n) acc[a][b][m][n] = (f32x4){0.f, 0.f, 0.f, 0.f};
        cur = nxt; cA = nA; cB = nB; ++ui;
        if constexpr (ALIGN_EPI) { if (wr == 1) PG8_BAR; }
    }
    PG8_WAIT_V(0);
    if constexpr (!ALIGN_EPI) { if (wr == 0) PG8_BAR; }
    PG8_BAR;
    if constexpr (Epi::AFTER_DRAIN) { E.fused(acc, cur, wr, wc, fr, fq, lds, wid, lane); S.done(cur); }
#undef PG8_SA
#undef PG8_SB
#undef PG8_STAGE
#undef PG8_LDA
#undef PG8_LDB
#undef PG8_MMA
#undef PG8_WAIT_V
#undef PG8_WAIT_L
#undef PG8_BAR
#undef PG8_SCHED
}
}
namespace attn_body {
using bf16=__hip_bfloat16;
using bf16x8=__attribute__((ext_vector_type(8)))short;
using s16x4=__attribute__((ext_vector_type(4)))short;
using f32x16=__attribute__((ext_vector_type(16)))float;
using u32x4=__attribute__((ext_vector_type(4)))unsigned;
using f32x4v=__attribute__((ext_vector_type(4)))float;
constexpr int BATCH=4,NHEAD=4,SEQ=8192,D=64,DM=2304,DMO=1024;
constexpr int NW=8,QBLK=32,QB=QBLK*NW,KVBLK=64,NQB=SEQ/QB;
constexpr int ATTN_PITCH=DM, ATTN_UNIT_ROWS=QB;
__device__ __forceinline__ int crow(int r,int hi){return (r&3)+8*(r>>2)+4*hi;}
#define SBAR() __builtin_amdgcn_sched_barrier(0)
__device__ __forceinline__ void cmask(f32x16&p0,f32x16&p1,int jb,int qrel,int hi){
  const float NEG=-INFINITY; int kb=64*jb+4*hi;
  #pragma unroll
  for(int r=0;r<16;++r){int kv=kb+(r&3)+8*(r>>2); if(kv>qrel)p0[r]=NEG; if(kv+32>qrel)p1[r]=NEG;}
}

constexpr int NSLOT=3, SLOTB=8192;
constexpr int LDS_K=0, LDS_V=NSLOT*SLOTB, LDS_WS=2*NSLOT*SLOTB, LDS_OST=LDS_WS+NW*64*4, LDS_BIAS=LDS_OST+NW*4096, LDS_BYTES=LDS_BIAS+SEQ*4+64;
constexpr float C2=0.125f*1.4426950408889634f;
__device__ __forceinline__ void glds16(const void*gsrc,unsigned lds_dst){unsigned keep;
  asm volatile("s_mov_b32 %0, m0\n\ts_mov_b32 m0, %2\n\ts_nop 0\n\tglobal_load_lds_dwordx4 %1, off\n\ts_mov_b32 m0, %0":"=&s"(keep):"v"(gsrc),"s"(lds_dst):"memory");}
__device__ __forceinline__ float max3f(float a,float b,float c){float r;asm("v_max3_f32 %0, %1, %2, %3":"=v"(r):"v"(a),"v"(b),"v"(c));return r;}
__device__ __forceinline__ float max2f(float a,float b){float r;asm("v_max_f32_e32 %0, %1, %2":"=v"(r):"v"(a),"v"(b));return r;}
__device__ __forceinline__ float fadd_s(float a,float b){float r;asm("v_add_f32_e32 %0, %1, %2":"=v"(r):"v"(a),"v"(b));return r;}
__device__ __forceinline__ float fsub_s(float a,float b){float r;asm("v_sub_f32_e32 %0, %1, %2":"=v"(r):"v"(a),"v"(b));return r;}
typedef float f32x2_t __attribute__((ext_vector_type(2))); typedef __bf16 bf16x2_t __attribute__((ext_vector_type(2)));
__device__ __forceinline__ unsigned cvtpk_s(float lo,float hi){f32x2_t v={lo,hi};bf16x2_t b=__builtin_convertvector(v,bf16x2_t);return __builtin_bit_cast(unsigned,b);}
#define WAIT_BAR(N) asm volatile("s_waitcnt vmcnt(" #N ") lgkmcnt(0)\n\ts_barrier":::"memory")

__device__ __forceinline__ void qkt(f32x16&p0,f32x16&p1,const char*Kslot,const bf16x8*qr,int r32,int hi){
  const char*kb=Kslot+hi*1024+r32*16;
  #pragma unroll
  for(int d0=0;d0<4;++d0){
    const bf16x8 b0=*reinterpret_cast<const bf16x8*>(kb+d0*2048);
    const bf16x8 b1=*reinterpret_cast<const bf16x8*>(kb+d0*2048+512);
    {p0=__builtin_amdgcn_mfma_f32_32x32x16_bf16(b0,qr[d0],p0,0,0,0);p1=__builtin_amdgcn_mfma_f32_32x32x16_bf16(b1,qr[d0],p1,0,0,0);}}
}
typedef __attribute__((address_space(3))) const char* lds_cptr;
typedef short v4i16_t __attribute__((ext_vector_type(4)));
__device__ __forceinline__ void kload8(bf16x8*kf,lds_cptr kp){
  kf[0]=*(const __attribute__((address_space(3))) bf16x8*)(kp);      kf[1]=*(const __attribute__((address_space(3))) bf16x8*)(kp+512);
  kf[2]=*(const __attribute__((address_space(3))) bf16x8*)(kp+2048); kf[3]=*(const __attribute__((address_space(3))) bf16x8*)(kp+2560);
  kf[4]=*(const __attribute__((address_space(3))) bf16x8*)(kp+4096); kf[5]=*(const __attribute__((address_space(3))) bf16x8*)(kp+4608);
  kf[6]=*(const __attribute__((address_space(3))) bf16x8*)(kp+6144); kf[7]=*(const __attribute__((address_space(3))) bf16x8*)(kp+6656);
}
__device__ __forceinline__ void kload2(bf16x8*kf,lds_cptr kp,int j){ kf[2*j]=*(const __attribute__((address_space(3))) bf16x8*)(kp+j*2048); kf[2*j+1]=*(const __attribute__((address_space(3))) bf16x8*)(kp+j*2048+512); }
__device__ __forceinline__ s16x4 vtr(lds_cptr p){ return __builtin_bit_cast(s16x4,__builtin_amdgcn_ds_read_tr16_b64_v4i16((__attribute__((address_space(3))) v4i16_t*)p)); }
__device__ __forceinline__ float rowmax(const f32x16&p0,const f32x16&p1){
  float a=max3f(p0[0],p0[1],p1[0]),b=max3f(p0[2],p0[3],p1[1]);a=max3f(a,p1[2],p1[3]);
  #pragma unroll
  for(int r=4;r<16;r+=4){a=max3f(a,p0[r],p0[r+1]);b=max3f(b,p0[r+2],p0[r+3]);a=max3f(a,p1[r],p1[r+1]);b=max3f(b,p1[r+2],p1[r+3]);}
  const float m=max2f(a,b);
  auto rr=__builtin_amdgcn_permlane32_swap(__float_as_uint(m),__float_as_uint(m),false,false);
  return max2f(__uint_as_float(rr[0]),__uint_as_float(rr[1]));
}
__device__ __forceinline__ void pv(f32x16*o,int vb,bf16x8 pa0,bf16x8 pa1,bf16x8 pa2,bf16x8 pa3){
  #pragma unroll
  for(int d0=0;d0<2;++d0){s16x4 lo[4],hi[4];
    #pragma unroll
    for(int ks=0;ks<4;++ks){
      asm volatile("ds_read_b64_tr_b16 %0,%1 offset:%c2":"=&v"(lo[ks]):"v"(vb),"i"(d0*4096+ks*1024):"memory");
      asm volatile("ds_read_b64_tr_b16 %0,%1 offset:%c2":"=&v"(hi[ks]):"v"(vb),"i"(d0*4096+ks*1024+512):"memory");}
    asm volatile("s_waitcnt lgkmcnt(0)":::"memory");SBAR();
    #define PK(k) (bf16x8){lo[k][0],lo[k][1],lo[k][2],lo[k][3],hi[k][0],hi[k][1],hi[k][2],hi[k][3]}
    o[d0]=__builtin_amdgcn_mfma_f32_32x32x16_bf16(pa0,PK(0),o[d0],0,0,0);
    o[d0]=__builtin_amdgcn_mfma_f32_32x32x16_bf16(pa1,PK(1),o[d0],0,0,0);
    o[d0]=__builtin_amdgcn_mfma_f32_32x32x16_bf16(pa2,PK(2),o[d0],0,0,0);
    o[d0]=__builtin_amdgcn_mfma_f32_32x32x16_bf16(pa3,PK(3),o[d0],0,0,0);
    #undef PK
  }
}

#ifndef ATTN_STORE16
#define ATTN_STORE16(p,v) (*(u32x4*)(p)=(v))
#endif
template<int THRL> __device__ __forceinline__ void attn_unit(int b,int h,int qb,const bf16*Q,const bf16*__restrict__ K,const bf16*__restrict__ V,bf16*O,const float*__restrict__ CB,const float*__restrict__ NRM,char*shm,int tid_in){
  int tid_raw_=tid_in; asm volatile("":"+v"(tid_raw_));
  const int tid=tid_raw_,lane=tid&63,r32=lane&31,hi=lane>>5; const int wid=__builtin_amdgcn_readfirstlane(tid>>6);
  const long rowbase=(long)b*SEQ; const int q0=qb*QB;
  const float cref=CB[q0];
  const bf16*Qw=Q+(rowbase+q0+wid*QBLK)*DM+h*D;
  bf16x8 qr[4];
  #pragma unroll
  for(int d0=0;d0<4;++d0)qr[d0]=*reinterpret_cast<const bf16x8*>(&Qw[(long)r32*DM+d0*16+hi*8]);
  {
    if(tid<128){ const int t=tid; bool skip=false;
      if(t<(q0+QB)/KVBLK-4){ const int gq=(b*SEQ+q0)>>6; float q2=0.f;
        _Pragma("unroll") for(int i=0;i<4;++i) q2=fmaxf(q2,NRM[(0*512+gq+i)*4+h]+NRM[(1*512+gq+i)*4+h]);
        float kb2=0.f; _Pragma("unroll") for(int i=0;i<4;++i) kb2=fmaxf(kb2,NRM[(2*512+gq+i)*4+h]+NRM[(3*512+gq+i)*4+h]);
        const int gk=(b*SEQ>>6)+t; const float k2=NRM[(2*512+gk)*4+h]+NRM[(3*512+gk)*4+h];
        skip=(cref-CB[64*t+63])+1.02f*sqrtf(q2)*(sqrtf(k2)+sqrtf(kb2))<-160.f; }
      const unsigned long long mk=__ballot(skip); if(lane==0)((__attribute__((address_space(3))) unsigned long long*)((lds_cptr)shm+LDS_BIAS+SEQ*4))[wid]=mk;
      if(tid==0){ const int gq=(b*SEQ+q0)>>6; float q2=0.f,kb2=0.f;
        _Pragma("unroll") for(int i=0;i<4;++i){ q2=fmaxf(q2,NRM[(0*512+gq+i)*4+h]+NRM[(1*512+gq+i)*4+h]); kb2=fmaxf(kb2,NRM[(2*512+gq+i)*4+h]+NRM[(3*512+gq+i)*4+h]); }
        ((__attribute__((address_space(3))) float*)((lds_cptr)shm+LDS_BIAS+SEQ*4))[4]=1.02f*sqrtf(q2*kb2); } }
    asm volatile("s_waitcnt vmcnt(0) lgkmcnt(0)\n\ts_barrier":::"memory"); }
  int T0;
  { const __attribute__((address_space(3))) unsigned long long* mkp=(const __attribute__((address_space(3))) unsigned long long*)((lds_cptr)shm+LDS_BIAS+SEQ*4);
    const unsigned long long m0=mkp[0],m1=mkp[1]; const int n0=(~m0)?__builtin_ctzll(~m0):64, n1=(~m1)?__builtin_ctzll(~m1):64;
    T0=(n0<64?n0:64+n1); const int ntall=(q0+QB)/KVBLK; T0&=~1; if(T0>ntall-4)T0=ntall-4; T0=__builtin_amdgcn_readfirstlane(T0); }
  { typedef __attribute__((address_space(3))) float lds_f; lds_f*btw=(lds_f*)((lds_cptr)shm+LDS_BIAS);
    for(int i=64*T0+tid;i<q0+QB;i+=NW*64) btw[i]=cref-CB[i];
    asm volatile("s_waitcnt vmcnt(0) lgkmcnt(0)\n\ts_barrier":::"memory"); }
  const bf16*Kh=K+(rowbase+(long)T0*KVBLK)*DM+h*D,*Vh=V+(rowbase+(long)T0*KVBLK)*DM+h*D;
  const unsigned lds0=(unsigned)(uintptr_t)shm;
  float*wsf=(float*)(shm+LDS_WS)+wid*64;
  const bf16*ksrc=Kh+(long)lane*DM+wid*8;
  const bf16*vsrc=Vh+(long)(16*(wid&3)+(lane>>2))*DM+(wid>>2)*32+(lane&3)*8;
  const unsigned kdst=lds0+LDS_K+wid*1024, vdst=lds0+LDS_V+wid*1024;
  #define DMA_K(t,slot) glds16(ksrc+(long)(t)*KVBLK*DM,(unsigned)__builtin_amdgcn_readfirstlane(kdst+(slot)))
  #define DMA_V(t,slot) glds16(vsrc+(long)(t)*KVBLK*DM,(unsigned)__builtin_amdgcn_readfirstlane(vdst+(slot)))
  const int vb0=(int)(lds0+LDS_V)+((lane>>4)&1)*32+(lane&3)*8+(4*hi+((lane&15)>>2))*64;
  const char*Kbase=shm+LDS_K; bf16x8 kf[8];
  const lds_cptr shm3=(lds_cptr)shm; const lds_cptr kp0=shm3+LDS_K+hi*1024+r32*16; const lds_cptr vp0=shm3+LDS_V+((lane>>4)&1)*32+(lane&3)*8+(4*hi+((lane&15)>>2))*64;
  const int NT=(q0+QB)/KVBLK-T0;
  DMA_K(0,0);DMA_V(0,0);DMA_K(1,SLOTB);
  typedef __attribute__((address_space(3))) const float lds_cf; typedef __attribute__((address_space(3))) const f32x4v lds_cf4;
  lds_cf*bt=(lds_cf*)((lds_cptr)shm+LDS_BIAS); lds_cf4*bt4=(lds_cf4*)((lds_cptr)shm+LDS_BIAS)+hi+16*T0;
  float mhat=bt[q0+wid*QBLK+r32]-((lds_cf*)((lds_cptr)shm+LDS_BIAS+SEQ*4))[4],l_reg=0.f;   f32x16 o[2];o[0]=f32x16{};o[1]=f32x16{};
  #define BINIT(P0,P1,t) do{ _Pragma("unroll") for(int g_=0;g_<4;++g_){ const f32x4v b0_=bt4[16*(t)+2*g_], b1_=bt4[16*(t)+8+2*g_]; \
      P0[4*g_]=b0_[0]-mhat;P0[4*g_+1]=b0_[1]-mhat;P0[4*g_+2]=b0_[2]-mhat;P0[4*g_+3]=b0_[3]-mhat; P1[4*g_]=b1_[0]-mhat;P1[4*g_+1]=b1_[1]-mhat;P1[4*g_+2]=b1_[2]-mhat;P1[4*g_+3]=b1_[3]-mhat; } }while(0)
  const int qrel=wid*QBLK+r32;
  #define CMASK(P0,P1,t) do{int jb_=(t)-(NT-4); if(jb_>=0)cmask(P0,P1,jb_,qrel,hi);}while(0)
  bool resc=false;
  #define START(P0,P1) do{ const float rm=rowmax(P0,P1); resc=false; \
    if(__any(rm>(float)THRL)){ const float dl=max2f(rm,0.f); mhat=fadd_s(mhat,dl); \
      _Pragma("unroll") for(int r=0;r<16;++r){P0[r]=fsub_s(P0[r],dl);P1[r]=fsub_s(P1[r],dl);} } \
    _Pragma("unroll") for(int r=0;r<16;++r)P0[r]=__builtin_amdgcn_exp2f(P0[r]); }while(0)
  #define RESC() do{ if(resc){ asm volatile("s_waitcnt lgkmcnt(0)":::"memory"); \
      _Pragma("unroll") for(int d_=0;d_<2;++d_) _Pragma("unroll") for(int r=0;r<16;++r)o[d_][r]*=wsf[crow(r,hi)]; } }while(0)
  f32x16 pA0,pA1,pB0,pB1;
  int sl_prev=0,sl_cur=0,sl_next=SLOTB;
  #define ROT() do{sl_prev=sl_cur;sl_cur=sl_next;sl_next=(sl_next==(NSLOT-1)*SLOTB)?0:sl_next+SLOTB;}while(0)
  DMA_K(2,2*SLOTB);
  WAIT_BAR(3);
  BINIT(pA0,pA1,0);qkt(pA0,pA1,Kbase,qr,r32,hi);asm volatile("s_nop 15\n\ts_nop 7":"+v"(pA0),"+v"(pA1));CMASK(pA0,pA1,0);
  START(pA0,pA1);
  _Pragma("unroll") for(int r=0;r<16;++r)pA1[r]=__builtin_amdgcn_exp2f(pA1[r]);
  WAIT_BAR(0);
  DMA_K(3,0);DMA_V(1,SLOTB);
  ROT();
  kload8(kf,kp0+sl_cur);
  WAIT_BAR(2);
  s16x4 vlo[8],vhi[8]; u32x4 pw0,pw1,pw2,pw3;
  #define PKW(P,B) cvtpk_s(P[B],P[B+1])
  #define PAF(k) __builtin_bit_cast(bf16x8,pw##k)
  #define VFR(i) (bf16x8){vlo[i][0],vlo[i][1],vlo[i][2],vlo[i][3],vhi[i][0],vhi[i][1],vhi[i][2],vhi[i][3]}
  #define PIN(x) asm volatile("":"+v"(x))
  #define MX3(a,b,c) __builtin_fmaxf(__builtin_fmaxf((a),(b)),(c))
  #define GAPA(MF,A0,A1,A2,A3,W0,W1,PW) do{ MF; sacc+=A0; sacc+=A1; sacc+=A2; sacc+=A3; PIN(sacc); W0; W1; PIN(PW); SBAR(); }while(0)
  #define EX(v) __builtin_amdgcn_exp2f(v)
  #define GAPB(MF,X,B) do{ MF; X[B]=EX(X[B]); X[B+1]=EX(X[B+1]); X[B+2]=EX(X[B+2]); X[B+3]=EX(X[B+3]); PIN(X); SBAR(); }while(0)
  #define VRD(i) do{ vlo[i]=vtr(vp_+(((i)>>2)*4096+((i)&3)*1024)); vhi[i]=vtr(vp_+(((i)>>2)*4096+((i)&3)*1024+512)); }while(0)
  #define KRD(G,j) do{ if(G){ kload2(kf,kp0+sl_next,j); SBAR(); } }while(0)
  #define STEP(C0,C1,P0,P1,t,GK,GV,GL) do{ SBAR(); BINIT(C0,C1,t); SBAR(); \
    const lds_cptr vp_=vp0+sl_prev; \
    VRD(0); SBAR(); float sacc=(P0[0]+P0[1]); \
    GAPA(C0=__builtin_amdgcn_mfma_f32_32x32x16_bf16(kf[0],qr[0],C0,0,0,0), P0[2],P0[3],P0[4],P0[5],     pw0[0]=PKW(P0,0), pw0[1]=PKW(P0,2), pw0); \
    VRD(4); SBAR(); GAPA(C1=__builtin_amdgcn_mfma_f32_32x32x16_bf16(kf[1],qr[0],C1,0,0,0), P0[6],P0[7],P0[8],P0[9],     pw0[2]=PKW(P0,4), pw0[3]=PKW(P0,6), pw0); \
    VRD(1); SBAR(); GAPA(C0=__builtin_amdgcn_mfma_f32_32x32x16_bf16(kf[2],qr[1],C0,0,0,0),   P0[10],P0[11],P0[12],P0[13], pw1[0]=PKW(P0,8), pw1[1]=PKW(P0,10), pw1); \
    VRD(5); SBAR(); GAPA(C1=__builtin_amdgcn_mfma_f32_32x32x16_bf16(kf[3],qr[1],C1,0,0,0),   P0[14],P0[15],P1[0],P1[1],   pw1[2]=PKW(P0,12),pw1[3]=PKW(P0,14), pw1); \
    VRD(2); SBAR(); GAPA(C0=__builtin_amdgcn_mfma_f32_32x32x16_bf16(kf[4],qr[2],C0,0,0,0),   P1[2],P1[3],P1[4],P1[5],     pw2[0]=PKW(P1,0), pw2[1]=PKW(P1,2), pw2); \
    VRD(6); SBAR(); GAPA(C1=__builtin_amdgcn_mfma_f32_32x32x16_bf16(kf[5],qr[2],C1,0,0,0),   P1[6],P1[7],P1[8],P1[9],     pw2[2]=PKW(P1,4), pw2[3]=PKW(P1,6), pw2); \
    VRD(3); SBAR(); GAPA(C0=__builtin_amdgcn_mfma_f32_32x32x16_bf16(kf[6],qr[3],C0,0,0,0),   P1[10],P1[11],P1[12],P1[13], pw3[0]=PKW(P1,8), pw3[1]=PKW(P1,10), pw3); \
    VRD(7); SBAR(); GAPA(C1=__builtin_amdgcn_mfma_f32_32x32x16_bf16(kf[7],qr[3],C1,0,0,0),   P1[14],P1[15],0.f,0.f,       pw3[2]=PKW(P1,12),pw3[3]=PKW(P1,14), pw3); \
    l_reg+=sacc; \
    if(GK){DMA_K((t)+3,sl_cur);} if(GV){DMA_V((t)+1,sl_next);} \
    CMASK(C0,C1,t); \
    { float a=MX3(C0[0],C0[1],C1[0]),b=MX3(C0[2],C0[3],C1[1]); a=MX3(a,C1[2],C1[3]); \
      _Pragma("unroll") for(int r=4;r<16;r+=4){a=MX3(a,C0[r],C0[r+1]);b=MX3(b,C0[r+2],C0[r+3]);a=MX3(a,C1[r],C1[r+1]);b=MX3(b,C1[r+2],C1[r+3]);} \
      float rm=__builtin_fmaxf(a,b); { auto rr=__builtin_amdgcn_permlane32_swap(__float_as_uint(rm),__float_as_uint(rm),false,false); rm=__builtin_fmaxf(__uint_as_float(rr[0]),__uint_as_float(rr[1])); } \
      resc=false; \
      if(__builtin_expect(__any(rm>(float)THRL),0)){ const float dl=__builtin_fmaxf(rm,0.f); mhat+=dl; \
        _Pragma("unroll") for(int r=0;r<16;++r){C0[r]-=dl;C1[r]-=dl;} \
        const float f=__builtin_amdgcn_exp2f(-dl); l_reg*=f; if(hi==0)wsf[r32]=f; resc=true; } } \
    SBAR(); \
    GAPB(o[0]=__builtin_amdgcn_mfma_f32_32x32x16_bf16(PAF(0),VFR(0),o[0],0,0,0), C0,0); \
    GAPB(o[1]=__builtin_amdgcn_mfma_f32_32x32x16_bf16(PAF(0),VFR(4),o[1],0,0,0), C0,4); \
    KRD(GL,0); GAPB(o[0]=__builtin_amdgcn_mfma_f32_32x32x16_bf16(PAF(1),VFR(1),o[0],0,0,0), C0,8); \
    KRD(GL,1); GAPB(o[1]=__builtin_amdgcn_mfma_f32_32x32x16_bf16(PAF(1),VFR(5),o[1],0,0,0), C0,12); \
    KRD(GL,2); GAPB(o[0]=__builtin_amdgcn_mfma_f32_32x32x16_bf16(PAF(2),VFR(2),o[0],0,0,0), C1,0); \
    KRD(GL,3); GAPB(o[1]=__builtin_amdgcn_mfma_f32_32x32x16_bf16(PAF(2),VFR(6),o[1],0,0,0), C1,4); \
    GAPB(o[0]=__builtin_amdgcn_mfma_f32_32x32x16_bf16(PAF(3),VFR(3),o[0],0,0,0), C1,8); \
    GAPB(o[1]=__builtin_amdgcn_mfma_f32_32x32x16_bf16(PAF(3),VFR(7),o[1],0,0,0), C1,12); \
    }while(0)
  int t=1;
  #undef CMASK
  #define CMASK(P0,P1,t) do{}while(0)
  for(;t+5<NT;t+=2){
    STEP(pB0,pB1,pA0,pA1,t,true,true,true);     WAIT_BAR(2); RESC(); ROT();
    STEP(pA0,pA1,pB0,pB1,t+1,true,true,true);   WAIT_BAR(2); RESC(); ROT();
  }
  #undef CMASK
  #define CMASK(P0,P1,t) do{int jb_=(t)-(NT-4); if(jb_>=0)cmask(P0,P1,jb_,qrel,hi);}while(0)
  #define ENDW(tt) do{ if((tt)+3<NT){WAIT_BAR(2);} else if((tt)+2<NT){WAIT_BAR(1);} else {WAIT_BAR(0);} }while(0)
  for(;t+1<NT;t+=2){
    STEP(pB0,pB1,pA0,pA1,t,(t+3<NT),(t+1<NT),(t+1<NT));       ENDW(t);   RESC(); ROT();
    STEP(pA0,pA1,pB0,pB1,t+1,(t+4<NT),(t+2<NT),(t+2<NT));     ENDW(t+1); RESC(); ROT();
  }
  STEP(pB0,pB1,pA0,pA1,NT-1,false,false,false); RESC();
  { float sacc=pB0[0]+pB0[1]; _Pragma("unroll") for(int r=2;r<16;++r)sacc+=pB0[r]; _Pragma("unroll") for(int r=0;r<16;++r)sacc+=pB1[r]; l_reg+=sacc;
    pw0=(u32x4){PKW(pB0,0),PKW(pB0,2),PKW(pB0,4),PKW(pB0,6)};pw1=(u32x4){PKW(pB0,8),PKW(pB0,10),PKW(pB0,12),PKW(pB0,14)};pw2=(u32x4){PKW(pB1,0),PKW(pB1,2),PKW(pB1,4),PKW(pB1,6)};pw3=(u32x4){PKW(pB1,8),PKW(pB1,10),PKW(pB1,12),PKW(pB1,14)};
    SBAR(); pv(o,vb0+sl_cur,PAF(0),PAF(1),PAF(2),PAF(3)); }
  #undef PKW
  #undef PAF
  #undef VFR
  #undef PIN
  #undef MX3
  #undef GAPA
  #undef GAPB
  #undef EX
  #undef VRD
  #undef KRD
  #undef STEP
  #undef ENDW
  {auto rr=__builtin_amdgcn_permlane32_swap(__float_as_uint(l_reg),__float_as_uint(l_reg),false,false);l_reg=__uint_as_float(rr[0])+__uint_as_float(rr[1]);}
  if(hi==0)wsf[32+r32]=l_reg;asm volatile("s_waitcnt lgkmcnt(0)":::"memory");
  float rli[16];
  #pragma unroll
  for(int r=0;r<16;++r)rli[r]=__builtin_amdgcn_rcpf(wsf[32+crow(r,hi)]);
  bf16*Ow=O+(rowbase+q0+wid*QBLK)*DMO+h*D;
  { bf16*stg=(bf16*)(shm+LDS_OST)+wid*2048;
    #pragma unroll
    for(int r=0;r<16;++r){const int orow=crow(r,hi);
      #pragma unroll
      for(int d0=0;d0<2;++d0)stg[orow*64+d0*32+r32]=__float2bfloat16(o[d0][r]*rli[r]);}
    asm volatile("s_waitcnt lgkmcnt(0)":::"memory");
    #pragma unroll
    for(int i=0;i<4;++i){const int row=i*8+(lane>>3),ch=lane&7; const u32x4 v=*(const u32x4*)(stg+row*64+ch*8); ATTN_STORE16(Ow+(long)row*DMO+ch*8,v);} }
  asm volatile("s_waitcnt lgkmcnt(0)\n\ts_barrier":::"memory");
  #undef DMA_K
  #undef DMA_V
  #undef CMASK
  #undef START
  #undef RESC
  #undef ROT
  #undef BINIT
}
constexpr int ATTN_LDS_BYTES=LDS_BYTES;
struct AttnTensors { const bf16* Q; const bf16* K; const bf16* V; bf16* O; const float* CB; const float* NRM; };
struct AttnUnit { int bh; int qb; };
struct StaticOrder {
  int vcu;
  __device__ __forceinline__ explicit StaticOrder(int grid,int block):vcu((block%8)*(grid/8)+block/8){}
  __device__ __forceinline__ bool next(int i,AttnUnit&u)const{ if(i>=2)return false; const int s=vcu&15; u.bh=vcu>>4; u.qb=(i==0)?31-s:s; return true; }
  __device__ __forceinline__ void a_ready(const AttnUnit&)const{}
  __device__ __forceinline__ void done(const AttnUnit&)const{}
};
template<class Sched,int THRL=8> __device__ __forceinline__ void attn_phase(char*lds,const AttnTensors&T,const Sched&S,int tid_in){
  AttnUnit u;
  for(int i=0;S.next(i,u);++i){ S.a_ready(u); attn_unit<THRL>(u.bh/NHEAD,u.bh%NHEAD,u.qb,T.Q,T.K,T.V,T.O,T.CB+(long)u.bh*SEQ,T.NRM,lds,tid_in); S.done(u); }
}
#undef SBAR
#undef WAIT_BAR
}
namespace cg = cooperative_groups;
constexpr int NWAVES = 8;
constexpr int BATCH = 4, SEQ = 8192, DM = 1024, M = BATCH * SEQ, DEPTH = 4, DIN = 2308, ZP = 2304, FF = 4096, DPLE = 256;
constexpr float EPS = 1e-6f;
constexpr float LOG2E = 1.4426950408889634f;
constexpr size_t MiB = 1u << 20;
constexpr size_t WS_BAR = 65536, WS_CTL_BYTES = 128 * 1024;
constexpr size_t WS_LF = 1 * MiB;
constexpr size_t WS_CB = 1 * MiB + 512 * 1024;
constexpr size_t WS_NRM = 3 * MiB;
constexpr size_t WS_RS = 3 * MiB + 65536;
constexpr size_t WS_WF = 2 * MiB;
constexpr size_t WS_W = 4 * MiB, W_STRIDE = 25 * MiB;
constexpr size_t WO_IN = 0, WO_O = 4 * MiB + 512 * 1024, WO_UP = WO_O + 2 * MiB, WO_DN = WO_UP + 8 * MiB, WO_G = WO_DN + 8 * MiB, WO_P = WO_G + 2 * MiB;
static_assert(WO_P + 512 * 1024 == W_STRIDE, "weights map");
constexpr size_t WS_XN = 104 * MiB;
constexpr size_t WS_G = 168 * MiB;
constexpr size_t WS_R = 232 * MiB;
constexpr size_t WS_Z = WS_R, WS_MC = WS_R + 144 * MiB, WS_UP = WS_R, WS_PROJ = WS_R, WS_PBF = WS_R + 256 * MiB;
constexpr size_t WS_END = WS_R + 256 * MiB + 16 * MiB;
constexpr int LDS_BYTES = 147456;

#define GAS __attribute__((address_space(1)))
#define LAS __attribute__((address_space(3)))
typedef unsigned short bf16;
typedef unsigned v4u __attribute__((ext_vector_type(4)));
typedef unsigned v2u __attribute__((ext_vector_type(2)));
typedef float f32x4 __attribute__((ext_vector_type(4)));
#define LDS_WAIT() asm volatile("s_waitcnt lgkmcnt(0)" ::: "memory")
typedef float f32x2_pk __attribute__((ext_vector_type(2))); typedef __bf16 bf16x2_pk __attribute__((ext_vector_type(2)));
__device__ __forceinline__ unsigned pk2(float lo, float hi) { const f32x2_pk v = {lo, hi}; return __builtin_bit_cast(unsigned, __builtin_convertvector(v, bf16x2_pk)); }
__device__ __forceinline__ unsigned f2bf(float f) { return pk2(f, 0.f) & 0xffffu; }
__device__ __forceinline__ float bflo(unsigned w) { return __uint_as_float(w << 16); }
__device__ __forceinline__ float bfhi(unsigned w) { return __uint_as_float(w & 0xffff0000u); }
__device__ __forceinline__ float bf1(bf16 v) { return __uint_as_float((unsigned)v << 16); }
__device__ __forceinline__ float sigm(float x) { return __builtin_amdgcn_rcpf(1.0f + __expf(-x)); }
__device__ __forceinline__ float wave_sum(float v) {
#pragma unroll
    for (int o = 1; o < 64; o <<= 1) v += __shfl_xor(v, o);
    return v;
}

__device__ __forceinline__ void tr_store(LAS float* scr, bf16* WT, int K, int drow0, int k0, int lane) {
    LDS_WAIT(); asm volatile("" ::: "memory");
    const int c = lane & 7;
#pragma unroll
    for (int j = 0; j < 4; ++j) { const int n = (lane >> 3) + 8 * j; const LAS float* s = scr + (8 * c) * 33 + n;
        v4u o; o.x = pk2(s[0 * 33], s[1 * 33]); o.y = pk2(s[2 * 33], s[3 * 33]); o.z = pk2(s[4 * 33], s[5 * 33]); o.w = pk2(s[6 * 33], s[7 * 33]);
        *(v4u*)(WT + (size_t)(drow0 + n) * K + k0 + 8 * c) = o; }
    LDS_WAIT(); asm volatile("" ::: "memory");
}
__device__ __forceinline__ void tr_item(const float* W, int ldw, int scol0, bf16* WT, int K, int drow0, int k0, LAS float* scr, int lane, const float* rg = nullptr  ) {
    f32x4 v[2][8];
#pragma unroll
    for (int h = 0; h < 2; ++h)
#pragma unroll
        for (int i = 0; i < 8; ++i) v[h][i] = *(const f32x4*)(W + (size_t)(k0 + 8 * i + (lane >> 3)) * ldw + scol0 + 32 * h + 4 * (lane & 7));
    if (rg) {
#pragma unroll
        for (int i = 0; i < 8; ++i) { const float gk = rg[k0 + 8 * i + (lane >> 3)]; v[0][i] = v[0][i] * gk; v[1][i] = v[1][i] * gk; } }
#pragma unroll
    for (int h = 0; h < 2; ++h) {
#pragma unroll
        for (int i = 0; i < 8; ++i) { LAS float* s = scr + (8 * i + (lane >> 3)) * 33 + 4 * (lane & 7); s[0] = v[h][i][0]; s[1] = v[h][i][1]; s[2] = v[h][i][2]; s[3] = v[h][i][3]; }
        tr_store(scr, WT, K, drow0 + 32 * h, k0, lane);
    }
}
__device__ __forceinline__ void tr_item_fold(const float* A, int lda, int J, const float* ps, const float* Wsrc, int jrow0, int n0, bf16* WT, int k0, LAS float* scr, int lane) {
    float acc[32];
#pragma unroll
    for (int n = 0; n < 32; ++n) acc[n] = 0.f;
    const float* arow = A + (size_t)lane * lda;
    for (int j = 0; j < J; j += 4) {
        const f32x4 a4 = *(const f32x4*)(arow + j);
#pragma unroll
        for (int jj = 0; jj < 4; ++jj) { const float* wr = Wsrc + (size_t)(jrow0 + j + jj) * 1024 + n0; const float a = ps ? a4[jj] * ps[j + jj] : a4[jj];
#pragma unroll
            for (int n = 0; n < 32; ++n) acc[n] += a * wr[n]; }
    }
#pragma unroll
    for (int n = 0; n < 32; ++n) scr[lane * 33 + n] = acc[n];
    tr_store(scr, WT, 1024, n0, k0, lane);
}

template <bool HAS_G, bool HAS_PRE, bool HAS_F, bool HAS_P, bool HIN32, bool HOUT32>
__device__ __forceinline__ void ephase(const void* hin_, const bf16* G, const float* gpost, void* hout_, const float* gpre, float* RS  , const f32x4* wf  , const float* bfg, float* LF,
                                       const float* psrc, bf16* pbf, int gw, int NGW, int lane) {
    f32x4 gp[4], gq[4], wfr[16];
#pragma unroll
    for (int j = 0; j < 4; ++j) { if (HAS_G) gp[j] = *(const f32x4*)(gpost + 4 * lane + 256 * j); if (HAS_PRE) gq[j] = *(const f32x4*)(gpre + 4 * lane + 256 * j); }
    if (HAS_F) {
#pragma unroll
        for (int j = 0; j < 4; ++j)
#pragma unroll
            for (int e = 0; e < 4; ++e) wfr[4 * j + e] = wf[(size_t)(4 * lane + 256 * j + e) * (DIN / 4)];
    }
    f32x4 h32[2][4]; v2u hbr[2][4], gbr[2][4]; f32x4 pvr[2];
#define E_LOAD(b_, mm_) do { const size_t q_ = (size_t)(mm_); _Pragma("unroll") for (int j = 0; j < 4; ++j) { \
        if (HIN32) h32[b_][j] = *(const f32x4*)((const float*)hin_ + q_ * DM + 4 * lane + 256 * j); else hbr[b_][j] = *(const v2u*)((const bf16*)hin_ + q_ * DM + 4 * lane + 256 * j); \
        if (HAS_G) gbr[b_][j] = *(const v2u*)(G + q_ * DM + 4 * lane + 256 * j); } \
        if (HAS_P) pvr[b_] = *(const f32x4*)(psrc + q_ * DPLE + 4 * lane); } while (0)
    E_LOAD(0, gw); E_LOAD(1, gw + NGW);
    for (int m0 = gw; m0 < M; m0 += 2 * NGW) {
#pragma unroll
      for (int u = 0; u < 2; ++u) { const int m = m0 + u * NGW;
        const size_t mm = (size_t)m;
        f32x4 v[4], g[4]; const f32x4 pv = pvr[u];
#pragma unroll
        for (int j = 0; j < 4; ++j) { if (HIN32) v[j] = h32[u][j]; else v[j] = (f32x4){bflo(hbr[u][j].x), bfhi(hbr[u][j].x), bflo(hbr[u][j].y), bfhi(hbr[u][j].y)};
            if (HAS_G) g[j] = (f32x4){bflo(gbr[u][j].x), bfhi(gbr[u][j].x), bflo(gbr[u][j].y), bfhi(gbr[u][j].y)}; }
        if (m + 2 * NGW < M) E_LOAD(u, m + 2 * NGW);
        if (HAS_G) {
            float ss = 0.f;
#pragma unroll
            for (int j = 0; j < 4; ++j) ss += (g[j][0] * g[j][0] + g[j][1] * g[j][1]) + (g[j][2] * g[j][2] + g[j][3] * g[j][3]);
            const float r = __builtin_amdgcn_rsqf(wave_sum(ss) * (1.f / DM) + EPS)    ;
#pragma unroll
            for (int j = 0; j < 4; ++j) { v[j] = v[j] + g[j] * r * gp[j];
                if (HOUT32) *(f32x4*)((float*)hout_ + mm * DM + 4 * lane + 256 * j) = v[j];
                else { v2u w; w.x = pk2(v[j][0], v[j][1]); w.y = pk2(v[j][2], v[j][3]); *(v2u*)((bf16*)hout_ + mm * DM + 4 * lane + 256 * j) = w; } }
        }
        if (!HAS_G && hout_) {
#pragma unroll
            for (int j = 0; j < 4; ++j) { v2u w; w.x = pk2(v[j][0], v[j][1]); w.y = pk2(v[j][2], v[j][3]); *(v2u*)((bf16*)hout_ + mm * DM + 4 * lane + 256 * j) = w; } }
        if (HAS_PRE) {
            float ss = 0.f;
#pragma unroll
            for (int j = 0; j < 4; ++j) ss += (v[j][0] * v[j][0] + v[j][1] * v[j][1]) + (v[j][2] * v[j][2] + v[j][3] * v[j][3]);
            const float r = __builtin_amdgcn_rsqf(wave_sum(ss) * (1.f / DM) + EPS)    ;
            if (lane == 0) RS[mm] = r;
            if (HAS_F) {
                float d0 = 0.f, d1 = 0.f, d2 = 0.f, d3 = 0.f;
#pragma unroll
                for (int j = 0; j < 4; ++j) { const f32x4 y = v[j] * r * gq[j];
#pragma unroll
                    for (int e = 0; e < 4; ++e) { const f32x4 wv = wfr[4 * j + e]; d0 += y[e] * wv[0]; d1 += y[e] * wv[1]; d2 += y[e] * wv[2]; d3 += y[e] * wv[3]; } }
                d0 = wave_sum(d0); d1 = wave_sum(d1); d2 = wave_sum(d2); d3 = wave_sum(d3);
                if (lane < 4) { float x = (lane == 0 ? d0 : lane == 1 ? d1 : lane == 2 ? d2 : d3) + bfg[lane];
                    LF[mm * 4 + lane] = fminf(x, 0.f) - log1pf(__expf(-fabsf(x))); }
            }
        }
        if (HAS_P) { v2u w; w.x = pk2(pv[0], pv[1]); w.y = pk2(pv[2], pv[3]); *(v2u*)(pbf + mm * DPLE + 4 * lane) = w; }
      }
    }
#undef E_LOAD
}

__device__ __forceinline__ void scan_block(LAS unsigned char* ldsb, const float* LF, float* CB, int bh, int tid, int lane, int wave) {
    const int b = bh >> 2, h = bh & 3; LAS double* wsum = (LAS double*)ldsb;
    float vals[16]; double s = 0.0;
#pragma unroll
    for (int i = 0; i < 16; ++i) { vals[i] = LF[((size_t)b * SEQ + tid * 16 + i) * 4 + h]; s += (double)vals[i]; }
    double inc = s;
#pragma unroll
    for (int o = 1; o < 64; o <<= 1) { const double t = __shfl_up(inc, o); if (lane >= o) inc += t; }
    if (lane == 63) wsum[wave] = inc;
    __syncthreads();
    double run = inc - s;
    for (int w = 0; w < wave; ++w) run += wsum[w];
#pragma unroll
    for (int i = 0; i < 16; ++i) { run += (double)vals[i]; CB[(size_t)bh * SEQ + tid * 16 + i] = (float)(run * 1.4426950408889634); }
    __syncthreads();
}

__device__ __forceinline__ void thin_tile(LAS unsigned char* ldsb, int tile, const bf16* Z, bf16* MC, const float* wdw, const float* lng, const float* lnb, const float* wsc, int tid, int lane, int wave) {
    const int b = tile >> 7, t0 = (tile & 127) * 64; const size_t rowbase = (size_t)b * SEQ;
    LAS float* U = (LAS float*)ldsb;
    {
        v2u ra[12], rg[12];
#pragma unroll
        for (int it_ = 0; it_ < 12; ++it_) { const int idx = tid + 512 * it_; const int r = idx >> 6, q4 = idx & 63, t = t0 - 30 + r;
            ra[it_] = (v2u){0u, 0u}; rg[it_] = (v2u){0u, 0u};
            if (idx < 94 * 64 && t >= 0) { const bf16* zp = Z + (rowbase + t) * ZP + 4 * q4; ra[it_] = *(const v2u*)zp; rg[it_] = *(const v2u*)(zp + 256); } }
#pragma unroll
        for (int it_ = 0; it_ < 12; ++it_) { const int idx = tid + 512 * it_; const int r = idx >> 6, q4 = idx & 63;
            if (idx < 94 * 64) { const v2u a = ra[it_], g = rg[it_]; f32x4 u;
                u[0] = bflo(a.x) * sigm(bflo(g.x)); u[1] = bfhi(a.x) * sigm(bfhi(g.x)); u[2] = bflo(a.y) * sigm(bflo(g.y)); u[3] = bfhi(a.y) * sigm(bfhi(g.y));
                *(LAS f32x4*)(U + r * 256 + 4 * q4) = u; } }
    }
    __syncthreads();
    const int c = tid & 255, half = tid >> 8;
    {
        typedef float f32x2c __attribute__((ext_vector_type(2)));
        float w[31]; f32x2c wp[32], acc2[16];
#pragma unroll
        for (int k = 0; k < 31; ++k) w[k] = wdw[k * 256 + c];
#pragma unroll
        for (int k = 0; k < 32; ++k) wp[k] = (f32x2c){k < 31 ? w[k] : 0.f, k >= 1 ? w[k - 1] : 0.f};
#pragma unroll
        for (int blk = 0; blk < 4; ++blk) {
#pragma unroll
            for (int pp = 0; pp < 4; ++pp) acc2[blk * 4 + pp] = (f32x2c){0.f, 0.f};
#pragma unroll
            for (int j = 0; j < 38; ++j) { const float x = U[(half * 32 + blk * 8 + j) * 256 + c]; const f32x2c xx = {x, x};
#pragma unroll
                for (int pp = 0; pp < 4; ++pp) { const int k = j - 2 * pp; if (k >= 0 && k <= 31) acc2[blk * 4 + pp] += wp[k] * xx; } }
        }
        __syncthreads();
#pragma unroll
        for (int i = 0; i < 16; ++i) { U[(half * 32 + 2 * i) * 256 + c] = acc2[i][0]; U[(half * 32 + 2 * i + 1) * 256 + c] = acc2[i][1]; }
    }
    __syncthreads();
    {
        const f32x4 g4 = *(const f32x4*)(lng + 4 * lane), b4 = *(const f32x4*)(lnb + 4 * lane);
#pragma unroll 2
        for (int i = 0; i < 8; ++i) { const int tok = wave * 8 + i; const f32x4 x = *(const LAS f32x4*)(U + tok * 256 + 4 * lane);
            const float mean = wave_sum((x[0] + x[1]) + (x[2] + x[3])) * (1.f / 256.f); const f32x4 d = x - mean;
            const float var = wave_sum((d[0] * d[0] + d[1] * d[1]) + (d[2] * d[2] + d[3] * d[3])) * (1.f / 256.f); const float rstd = __builtin_amdgcn_rsqf(var + EPS);
            f32x4 y = d * rstd * g4 + b4; y[0] *= sigm(y[0]); y[1] *= sigm(y[1]); y[2] *= sigm(y[2]); y[3] *= sigm(y[3]);
            v2u o; o.x = pk2(y[0], y[1]); o.y = pk2(y[2], y[3]); *(v2u*)(MC + (rowbase + t0 + tok) * DM + 4 * lane) = o; }
    }
    __syncthreads();
    const int ts = t0 + half * 32;
    {
        const float w0 = wsc[c], w1 = wsc[256 + c], w2 = wsc[512 + c];
        float gm2 = 0.f, gm1 = 0.f;
        if (ts >= 2) { const bf16* zp = Z + (rowbase + ts - 2) * ZP; gm2 = bf1(zp[1792 + c]) * bf1(zp[1280 + c]); zp += ZP; gm1 = bf1(zp[1792 + c]) * bf1(zp[1280 + c]); }
#pragma unroll 1
        for (int t8 = 0; t8 < 32; t8 += 16) { const bf16* zp = Z + (rowbase + ts + t8) * ZP + c; bf16 rh[16], rc[16], rb[16];
#pragma unroll
            for (int i = 0; i < 16; ++i) { rh[i] = zp[i * ZP + 1280]; rc[i] = zp[i * ZP + 1792]; rb[i] = zp[i * ZP + 1536]; }
#pragma unroll
            for (int i = 0; i < 16; ++i) { const float g = bf1(rc[i]) * bf1(rh[i]); const float y = bf1(rb[i]) * (w0 * gm2 + w1 * gm1 + w2 * g);
                MC[(rowbase + ts + t8 + i) * DM + 512 + c] = (bf16)f2bf(y); gm2 = gm1; gm1 = g; } }
    }
    {
        const int grp = c >> 6, wi = 2 << grp; const float rinv = 1.0f / (float)wi;
        float vm1 = 0.f, s2c[2] = {0.f, 0.f}, s4c[4], s8c[8];
#pragma unroll
        for (int i = 0; i < 4; ++i) s4c[i] = 0.f;
#pragma unroll
        for (int i = 0; i < 8; ++i) s8c[i] = 0.f;
#pragma unroll 1
        for (int t16 = -16; t16 < 32; t16 += 24) { bf16 rv[24];
#pragma unroll
            for (int i = 0; i < 24; ++i) { const int t = ts + t16 + i; rv[i] = Z[(rowbase + (t >= 0 ? t : 0)) * ZP + 2048 + c]; }
#pragma unroll
            for (int i = 0; i < 24; ++i) { const int tt = t16 + i, t = ts + tt; const float v = t >= 0 ? bf1(rv[i]) : 0.f;
                const float s2 = v + vm1, s4 = s2 + s2c[i & 1], s8 = s4 + s4c[i & 3], s16 = s8 + s8c[i & 7];
                s2c[i & 1] = s2; s4c[i & 3] = s4; s8c[i & 7] = s8; vm1 = v;
                if (tt >= 0) { const float sw = grp == 0 ? s2 : grp == 1 ? s4 : grp == 2 ? s8 : s16; const float ri = (t + 1 >= wi) ? rinv : __builtin_amdgcn_rcpf((float)(t + 1));
                    MC[(rowbase + t) * DM + 768 + c] = (bf16)f2bf(sw * ri - v); } } }
    }
}

#define XB_TMO      128
#define XB_XCNT(j)  (256  + 64 * (j))
#define XB_XSUB(j)  (1280 + 64 * (j))
#define XB_XGEN(j)  (2304 + 64 * (j))
#define XB_TOP      3328
#define XB_TOPGEN   3392
#define XCD_BAR_WORDS 3456
#define XB_SPIN_CAP (1u << 18)

__device__ __forceinline__ unsigned xb_ld(unsigned* p)              { return __hip_atomic_load(p, __ATOMIC_RELAXED, __HIP_MEMORY_SCOPE_AGENT); }
__device__ __forceinline__ unsigned xb_add(unsigned* p, unsigned v) { return __hip_atomic_fetch_add(p, v, __ATOMIC_RELAXED, __HIP_MEMORY_SCOPE_AGENT); }
__device__ __forceinline__ unsigned xb_xcc_id() { return (unsigned)__builtin_amdgcn_s_getreg((3 << 11) | 20) & 0xFu; }
#define XB_SPIN(cond, bar) do { unsigned _sp = 0; while (cond) { __builtin_amdgcn_s_sleep(1); \
    if ((++_sp & 255u) == 0u) { if (xb_ld(&(bar)[XB_TMO])) break; if (_sp > XB_SPIN_CAP) { atomicAdd(&(bar)[XB_TMO], 1u); break; } } } } while (0)

struct XcdBarrier {
    unsigned* bar; unsigned x;
    volatile LAS unsigned* st;
};

__device__ __forceinline__ XcdBarrier xcd_barrier_post(unsigned* bar, volatile LAS unsigned* st) {
    XcdBarrier b; b.bar = bar; b.x = xb_xcc_id(); b.st = st;
    if (threadIdx.x == 0) (void)xb_add(&bar[XB_XCNT(b.x)], 1u);
    return b;
}
__device__ __forceinline__ void xcd_barrier_complete(unsigned* bar, unsigned x, unsigned& nloc, unsigned& nx) {
    const unsigned G = gridDim.x * gridDim.y * gridDim.z;
    unsigned sum, cnt, mine, sp = 0u;
    for (;;) {
        sum = 0u; cnt = 0u; mine = 0u;
#pragma unroll
        for (unsigned j = 0; j < 16; ++j) { const unsigned c = xb_ld(&bar[XB_XCNT(j)]); sum += c; cnt += (c > 0u) ? 1u : 0u; mine = (j == x) ? c : mine; }
        if (sum == G) break;
        __builtin_amdgcn_s_sleep(1);
        if ((++sp & 255u) == 0u) { if (xb_ld(&bar[XB_TMO])) break; if (sp > XB_SPIN_CAP) { atomicAdd(&bar[XB_TMO], 1u); break; } }
    }
    nloc = mine > 0u ? mine : 1u; nx = cnt > 0u ? cnt : 1u;
}

__device__ __forceinline__ void xcd_barrier(const XcdBarrier& b, int tid_in) {
    asm volatile("s_waitcnt vmcnt(0)" ::: "memory");
    __syncthreads();
    if (tid_in == 0) {
        unsigned* bar = b.bar;
        __builtin_amdgcn_s_waitcnt(0);
        unsigned nloc = b.st[0], nx = b.st[1];
        if (nloc == 0u) { xcd_barrier_complete(bar, b.x, nloc, nx); b.st[0] = nloc; b.st[1] = nx; }
        const unsigned old = xb_add(&bar[XB_XSUB(b.x)], 1u);
        const unsigned gen = old / nloc;
        if (old + 1u == (gen + 1u) * nloc) {
            __builtin_amdgcn_fence(__ATOMIC_RELEASE, "agent");
            asm volatile("s_waitcnt vmcnt(0)" ::: "memory");
            const unsigned og = xb_add(&bar[XB_TOP], 1u);
            const unsigned tg = og / nx;
            if (og + 1u == (tg + 1u) * nx) xb_add(&bar[XB_TOPGEN], 1u);
            else XB_SPIN(xb_ld(&bar[XB_TOPGEN]) == tg, bar);
            __builtin_amdgcn_fence(__ATOMIC_ACQUIRE, "agent");
            xb_add(&bar[XB_XGEN(b.x)], 1u);
            asm volatile("s_waitcnt vmcnt(0)" ::: "memory");
        } else {
            XB_SPIN(xb_ld(&bar[XB_XGEN(b.x)]) == gen, bar);
            __builtin_amdgcn_fence(__ATOMIC_ACQUIRE, "agent");
            asm volatile("s_waitcnt vmcnt(0)" ::: "memory");
        }
    }
    __syncthreads();
}

#ifndef MK_SPLIT
#define MK_SPLIT 0
#endif
typedef unsigned char* ws_ptr_t;
struct Args { const float* in[22]; float* out; unsigned char* ws; int ph_lo, ph_hi; };
enum { I_X = 0, I_P, I_GMIXPRE, I_WIN, I_BF, I_WDW, I_LNG, I_LNB, I_WPW, I_WSC, I_WPOOL, I_PSC, I_WOUT, I_GMIXPOST, I_GMLPPRE, I_WUP, I_WDN, I_GMLPPOST, I_GPLEPRE, I_WG, I_WP, I_GPLEPOST };

__global__ void __launch_bounds__(NWAVES * 64, 2) mk_fwd(Args args) {
    extern __shared__ __attribute__((aligned(16))) unsigned char lds[];
    cg::grid_group grid = cg::this_grid();
    LAS unsigned char* ldsb = (LAS unsigned char*)lds;
#define IDS() int tid = threadIdx.x; asm volatile("" : "+v"(tid)); int G = gridDim.x, bx = blockIdx.x; asm volatile("" : "+s"(G), "+s"(bx)); \
    const int vcu = (G % 8 == 0) ? (bx % 8) * (G / 8) + bx / 8 : bx, NGW = G * NWAVES, lane = tid & 63, wave = __builtin_amdgcn_readfirstlane(tid >> 6), gw = vcu * NWAVES + wave; (void)lane; (void)gw; (void)NGW;
    if (threadIdx.x < 64) ((LAS unsigned*)(ldsb + 131072))[threadIdx.x] = 0u;
    __syncthreads();
#define MKBAR() XcdBarrier bar; bar.bar = (unsigned*)(WSP() + WS_BAR); bar.x = xb_xcc_id(); bar.st = (volatile LAS unsigned*)(ldsb + 131072 + 32);
    typedef __attribute__((address_space(4))) const unsigned char* kptr_t; typedef const float* cfp_t; typedef unsigned char* ucp_t;
#define KARG() ({ kptr_t k_ = (kptr_t)__builtin_amdgcn_kernarg_segment_ptr(); asm volatile("" : "+s"(k_)); k_; })
#define INP(i) (*(const __attribute__((address_space(4))) cfp_t*)(KARG() + 8 * (i)))
#define WSP() (*(const __attribute__((address_space(4))) ucp_t*)(KARG() + 184))
#define LF ((float*)(WSP() + WS_LF))
#define CB ((float*)(WSP() + WS_CB))
#define WF ((f32x4*)(WSP() + WS_WF))
#define RS ((float*)(WSP() + WS_RS))
#define HB ((bf16*)(WSP() + WS_XN))
#define GB ((bf16*)(WSP() + WS_G))
#define Z ((bf16*)(WSP() + WS_Z))
#define MC ((bf16*)(WSP() + WS_MC))
#define UP ((bf16*)(WSP() + WS_UP))
#define PROJ ((bf16*)(WSP() + WS_PROJ))
#define PBF ((bf16*)(WSP() + WS_PBF))
#define HOUT ((float*)(*(const __attribute__((address_space(4))) ucp_t*)(KARG() + 176)))
#if MK_SPLIT
    const int lo = *(const __attribute__((address_space(4))) int*)(KARG() + 192), hi = *(const __attribute__((address_space(4))) int*)(KARG() + 196);
#endif
    { (void)xcd_barrier_post((unsigned*)(WSP() + WS_BAR), (volatile LAS unsigned*)(ldsb + 131072 + 32)); }
#if MK_SPLIT
#define IN(k) (lo <= (k) && (k) < hi)
#else
#define IN(k) true
#endif
    if (*(const __attribute__((address_space(4))) int*)(KARG() + 192) < 0) grid.sync();
#define SEAM(k) do { if (IN(k) && IN((k) + 1)) { MKBAR(); xcd_barrier(bar, (int)threadIdx.x); } } while (0)

    if (IN(0)) {
        IDS();
#ifndef NO_PRO
        LAS float* scr = (LAS float*)(ldsb + wave * 16384);
        constexpr int I_IN1 = 16 * 40, I_IN2 = 16 * 32, I_O = 16 * 32, I_UP = 16 * 128, I_DN = 64 * 32, I_G = 16 * 32, I_PP = 4 * 32, I_LAYER = I_IN1 + I_IN2 + I_O + I_UP + I_DN + I_G + I_PP;
        static_assert(I_LAYER - 256 == 6144 && DEPTH * 128 == 512, "prologue deal");
        const int cls = gw & 3, ci = gw >> 2;
        const int pcnt = cls == 0 ? 4 : cls == 1 ? 7 : 8, pbeg = cls == 0 ? ci * 3 : cls == 1 ? 1536 + ci * 6 : 4608 + ci * 2 + (cls - 2), pstep = cls < 2 ? 1 : 1024;
        for (int step = 0; step < 2; ++step) {
        if (((step ^ wave) & 1) == 0) {
        for (int sl = 0; sl < pcnt; ++sl) {
            int l, r;
            if (cls < 2 && sl == 0) { l = ci >> 7; r = (cls == 0 ? 0 : 384) + (ci & 127); }
            else { const int p = pbeg + (cls < 2 ? sl - 1 : sl) * pstep; if (p >= DEPTH * 3072) break; l = p / 3072; const int rr = 2 * (p % 3072); r = rr < 256 ? 128 + rr : rr + 256; }
            unsigned char* wl = WSP() + WS_W + (size_t)l * W_STRIDE;
            if (r < I_O) {
                const int kb = r / 32, nb = r % 32, k0 = 64 * kb; const float* wout = INP(I_WOUT) + (size_t)l * 1024 * 1024;
                if (kb < 4) tr_item_fold(INP(I_WPW) + (size_t)l * 65536 + (size_t)k0 * 256, 256, 256, nullptr, wout, 0, 32 * nb, (bf16*)(wl + WO_O), k0, scr, lane);
                else if (kb >= 12) { const int g = kb - 12; tr_item_fold(INP(I_WPOOL) + (size_t)l * 16384 + (size_t)g * 4096, 64, 64, INP(I_PSC) + l * 256 + 64 * g, wout, 768 + 64 * g, 32 * nb, (bf16*)(wl + WO_O), k0, scr, lane); }
                else tr_item(wout, 1024, 32 * nb, (bf16*)(wl + WO_O), 1024, 32 * nb, k0, scr, lane);
                continue; } r -= I_O;
            if (r < I_IN1) { const int kb = r / 40, nb = r % 40; tr_item(INP(I_WIN) + (size_t)l * 1024 * DIN, DIN, 32 * nb, (bf16*)(wl + WO_IN), 1024, 32 * nb, 64 * kb, scr, lane, INP(I_GMIXPRE) + l * 1024); continue; } r -= I_IN1;
            if (r < I_IN2) { const int kb = r / 32, nb = r % 32; tr_item(INP(I_WIN) + (size_t)l * 1024 * DIN, DIN, 1284 + 32 * nb, (bf16*)(wl + WO_IN), 1024, 1280 + 32 * nb, 64 * kb, scr, lane, INP(I_GMIXPRE) + l * 1024); continue; } r -= I_IN2;
            if (r < I_UP) { const int kb = r / 128, nb = r % 128; tr_item(INP(I_WUP) + (size_t)l * 1024 * FF, FF, 32 * nb, (bf16*)(wl + WO_UP), 1024, 32 * nb, 64 * kb, scr, lane, INP(I_GMLPPRE) + l * 1024); continue; } r -= I_UP;
            if (r < I_DN) { const int kb = r / 32, nb = r % 32; tr_item(INP(I_WDN) + (size_t)l * FF * 1024, 1024, 32 * nb, (bf16*)(wl + WO_DN), FF, 32 * nb, 64 * kb, scr, lane); continue; } r -= I_DN;
            if (r < I_G) { const int kb = r / 32, nb = r % 32; tr_item(INP(I_WG) + (size_t)l * 1024 * 1024, 1024, 32 * nb, (bf16*)(wl + WO_G), 1024, 32 * nb, 64 * kb, scr, lane, INP(I_GPLEPRE) + l * 1024); continue; } r -= I_G;
            { const int kb = r / 32, nb = r % 32; tr_item(INP(I_WP) + (size_t)l * DPLE * 1024, 1024, 32 * nb, (bf16*)(wl + WO_P), DPLE, 32 * nb, 64 * kb, scr, lane); }
        }
        } else
        ephase<false, true, true, false, true, false>(INP(I_X), nullptr, nullptr, HB, INP(I_GMIXPRE), RS, (const f32x4*)(INP(I_WIN) + 1280), INP(I_BF), LF, nullptr, nullptr, gw, NGW, lane);
        }
#endif
        __syncthreads();
    }
    SEAM(0);

#pragma unroll 1
    for (int l = 0; l < DEPTH; ++l) {
        const int pb = 1 + 11 * l;
#define wl (WSP() + WS_W + (size_t)l * W_STRIDE)
        if (IN(pb + 1)) {
            IDS();
            if (bx >= 128 && bx < 144) scan_block(ldsb, LF, CB, bx - 128, tid, lane, wave);
            pg8::Gemm g{HB, (const bf16*)(wl + WO_IN), M, ZP, 1024}; pg8::StaticOrder S; S.init(M, ZP, G, bx);
            pg8::EpiT<2> E{Z, ZP, nullptr, 2, attn_body::C2, (float*)(WSP() + WS_NRM), RS};
#ifndef NO_GEMM1
            pg8::gemm_phase<pg8::EpiT<2>, pg8::StaticOrder, true, true>(ldsb, g, S, E, tid);
#endif
            if (bx >= 128) {
                const float* psrc = INP(I_P) + (size_t)l * M * DPLE; bf16* pdst = PBF; const int w0 = (bx - 128) * NWAVES + wave;
                for (int m = w0; m < M; m += 128 * NWAVES * 4) { f32x4 pv[4];
#pragma unroll
                    for (int i = 0; i < 4; ++i) pv[i] = *(const f32x4*)(psrc + (size_t)(m + i * 128 * NWAVES) * DPLE + 4 * lane);
#pragma unroll
                    for (int i = 0; i < 4; ++i) { v2u w; w.x = pk2(pv[i][0], pv[i][1]); w.y = pk2(pv[i][2], pv[i][3]); *(v2u*)(pdst + (size_t)(m + i * 128 * NWAVES) * DPLE + 4 * lane) = w; } }
            }
        }
        SEAM(pb + 1);
        if (IN(pb + 2)) {
            IDS();
#ifndef NO_THIN
            for (int tile = vcu; tile < M / 64; tile += G)
                thin_tile(ldsb, tile, Z, MC, INP(I_WDW) + (size_t)l * 31 * 256, INP(I_LNG) + l * 256, INP(I_LNB) + l * 256, INP(I_WSC) + l * 768, tid, lane, wave);
#endif
            const attn_body::AttnTensors AT{(const attn_body::bf16*)(Z + 512), (const attn_body::bf16*)(Z + 768), (const attn_body::bf16*)(Z + 1024), (attn_body::bf16*)(MC + 256), CB, (const float*)(WSP() + WS_NRM)};
            const attn_body::StaticOrder S(G, bx);
#ifndef NO_ATTN
            attn_body::attn_phase<attn_body::StaticOrder>((char*)lds, AT, S, tid);
#endif
        }
        SEAM(pb + 2);
        if (IN(pb + 3)) {
            IDS();
            pg8::Gemm g{MC, (const bf16*)(wl + WO_O), M, 1024, 1024}; pg8::StaticOrder S; S.init(M, 1024, G, bx);
            pg8::EpiT<0> E{GB, 1024, nullptr, 0, 1.f, nullptr, nullptr};
#ifndef NO_GEMM2
            pg8::gemm_phase<pg8::EpiT<0>, pg8::StaticOrder, true, true>(ldsb, g, S, E, tid);
#endif
        }
        SEAM(pb + 3);
        if (IN(pb + 4)) { IDS();
            ephase<true, true, false, false, false, false>(HB, GB, INP(I_GMIXPOST) + l * 1024, HB, INP(I_GMLPPRE) + l * 1024, RS, nullptr, nullptr, nullptr, nullptr, nullptr, gw, NGW, lane); }
        SEAM(pb + 4);
        if (IN(pb + 5)) {
            IDS();
            pg8::Gemm g{HB, (const bf16*)(wl + WO_UP), M, FF, 1024}; pg8::StaticOrder S; S.init(M, FF, G, bx);
            pg8::EpiT<1> E{UP, FF, nullptr, 0, 1.f, nullptr, RS};
#ifndef NO_GEMM3
            pg8::gemm_phase<pg8::EpiT<1>, pg8::StaticOrder, true, true>(ldsb, g, S, E, tid);
#endif
        }
        SEAM(pb + 5);
        if (IN(pb + 6)) {
            IDS();
            pg8::Gemm g{UP, (const bf16*)(wl + WO_DN), M, 1024, FF}; pg8::StaticOrder S; S.init(M, 1024, G, bx);
            pg8::EpiT<0> E{GB, 1024, nullptr, 0, 1.f, nullptr, nullptr};
#ifndef NO_GEMM4
            pg8::gemm_phase<pg8::EpiT<0>, pg8::StaticOrder, true, true>(ldsb, g, S, E, tid);
#endif
        }
        SEAM(pb + 6);
        if (IN(pb + 7)) { IDS(); ephase<true, true, false, false, false, false>(HB, GB, INP(I_GMLPPOST) + l * 1024, HB, INP(I_GPLEPRE) + l * 1024, RS, nullptr, nullptr, nullptr, nullptr, nullptr, gw, NGW, lane); }
        SEAM(pb + 7);
        if (IN(pb + 8)) {
            IDS();
            pg8::Gemm g{PBF, (const bf16*)(wl + WO_P), M, 1024, DPLE}; pg8::StaticOrder S; S.init(M, 1024, G, bx);
            pg8::EpiT<0> E{PROJ, 1024, nullptr, 0, 1.f, nullptr, nullptr};
#ifndef NO_GEMM5
            pg8::gemm_phase<pg8::EpiT<0>, pg8::StaticOrder, true, true>(ldsb, g, S, E, tid);
#endif
        }
        if (IN(pb + 9)) {
            IDS();
            asm volatile("s_waitcnt vmcnt(0)" ::: "memory"); __builtin_amdgcn_fence(__ATOMIC_ACQUIRE, "agent");
            pg8::Gemm g{HB, (const bf16*)(wl + WO_G), M, 1024, 1024}; pg8::StaticOrder S; S.init(M, 1024, G, bx);
            pg8::EpiT<3> E{GB, 1024, PROJ, 0, 1.f, nullptr, RS};
#ifndef NO_GEMM6
            pg8::gemm_phase<pg8::EpiT<3>, pg8::StaticOrder, true, true>(ldsb, g, S, E, tid);
#endif
        }
        SEAM(pb + 9);
        if (IN(pb + 10)) {
            IDS();
            if (l + 1 < DEPTH) ephase<true, true, true, false, false, false>(HB, GB, INP(I_GPLEPOST) + l * 1024, HB, INP(I_GMIXPRE) + (l + 1) * 1024, RS, (const f32x4*)(INP(I_WIN) + (size_t)(l + 1) * 1024 * DIN + 1280), INP(I_BF) + (l + 1) * 4, LF, nullptr, nullptr, gw, NGW, lane);
            else ephase<true, false, false, false, false, true>(HB, GB, INP(I_GPLEPOST) + l * 1024, HOUT, nullptr, nullptr, nullptr, nullptr, nullptr, nullptr, nullptr, gw, NGW, lane);
        }
        SEAM(pb + 10);
    }
#undef IN
#undef SEAM
#undef KARG
#undef INP
#undef WSP
#undef LF
#undef CB
#undef WF
#undef RS
#undef GB
#undef Z
#undef MC
#undef UP
#undef PROJ
#undef PBF
#undef HOUT
#undef HB
#undef wl
#undef IDS
#undef MKBAR
}
constexpr int N_PHASES = 1 + 11 * DEPTH;

extern "C" void kernel_launch(void* const* d_in, const int* in_sizes, int n_in, void* d_out, int out_size, void* d_ws, size_t ws_size, hipStream_t stream) {
    static int grid = 0;
    if (grid == 0) {
        if (n_in != 22 || out_size != M * DM || ws_size < WS_END) { fprintf(stderr, "kernel_launch: unexpected problem (n_in %d, out %d, ws %zu); nothing launched\n", n_in, out_size, ws_size); grid = -1; return; }
        int dev = 0, cus = 0;
        if (hipGetDevice(&dev) != hipSuccess || hipDeviceGetAttribute(&cus, hipDeviceAttributeMultiprocessorCount, dev) != hipSuccess) { grid = -1; return; }
        if (hipFuncSetAttribute((const void*)mk_fwd, hipFuncAttributeMaxDynamicSharedMemorySize, LDS_BYTES) != hipSuccess) { fprintf(stderr, "kernel_launch: hipFuncSetAttribute failed\n"); grid = -1; return; }
        int per_cu = 0;
        if (hipOccupancyMaxActiveBlocksPerMultiprocessor(&per_cu, (const void*)mk_fwd, NWAVES * 64, LDS_BYTES) != hipSuccess || per_cu < 1) fprintf(stderr, "kernel_launch: occupancy query says %d\n", per_cu);
        (void)hipGetLastError();
        grid = cus;
        if (grid != 256) fprintf(stderr, "kernel_launch: %d CUs; this kernel is dealt for 256\n", grid);
    }
    if (grid < 0) return;
    if (hipMemsetAsync(d_ws, 0, WS_CTL_BYTES, stream) != hipSuccess) { fprintf(stderr, "kernel_launch: memset failed\n"); return; }
    Args a{};
    for (int i = 0; i < 22; ++i) a.in[i] = (const float*)d_in[i];
    a.out = (float*)d_out; a.ws = (unsigned char*)d_ws;
#if MK_SPLIT
    for (int p = 0; p < N_PHASES; ++p) { a.ph_lo = p; a.ph_hi = p + 1; hipLaunchKernelGGL(mk_fwd, dim3(grid), dim3(NWAVES * 64), LDS_BYTES, stream, a); }
#else
    a.ph_lo = 0; a.ph_hi = N_PHASES;
    void* kargs[] = {&a};
    const hipError_t e = hipLaunchCooperativeKernel((const void*)mk_fwd, dim3(grid), dim3(NWAVES * 64), kargs, LDS_BYTES, stream);
    if (e != hipSuccess) fprintf(stderr, "kernel_launch: cooperative launch failed: %s\n", hipGetErrorString(e));
#endif
}
```

```cpp
#include <hip/hip_runtime.h>
#include <hip/hip_cooperative_groups.h>
#include <hip/hip_bf16.h>
#include <cstdio>
#include <cstdint>
#include <cmath>
namespace pg8 {
#define PG8_LAS __attribute__((address_space(3)))
typedef unsigned short bf16_t;
typedef short bf16x8 __attribute__((ext_vector_type(8)));
typedef float f32x4 __attribute__((ext_vector_type(4)));
typedef unsigned u32x4 __attribute__((ext_vector_type(4)));
constexpr int BM = 256, BK = 64, HALF = 128, HTB = HALF * BK * 2  , STAGE_BYTES = 8 * HTB, NXCD = 8, WGM = 4;

__host__ __device__ __forceinline__ int lds_byte(int r, int c) { const int st = (r >> 4) * 2 + (c >> 5), rr = r & 15, cc = c & 31, ob = rr * 64 + cc * 2; return st * 1024 + (ob ^ (((ob >> 9) & 1) << 5)); }
__host__ __device__ __forceinline__ void stage_rc(int b, int& R, int& C) { const int st = b / 1024, sb = b % 1024, swz = sb ^ (((sb >> 9) & 1) << 5); R = (st >> 1) * 16 + swz / 64; C = (st & 1) * 32 + (swz % 64) / 2; }
__host__ __device__ __forceinline__ int perm32(int rho) { const int n = rho >> 4, i = rho & 15; return 8 * (i >> 2) + 4 * n + (i & 3); }

struct Unit { int pm, pn; };
struct Gemm { const bf16_t* A; const bf16_t* Bt; int M, N, K; };

struct StaticOrder {
    int nM, nN, nwg, G, c;
    __host__ __device__ void init(int M, int N, int G_, int c_) { nM = M / BM; nN = N / BM; nwg = nM * nN; G = G_; c = c_; }
    __host__ __device__ bool next(int i, Unit& u) const {
        const long L = (long)i * G + c; if (L >= nwg) return false;
        int wgid = (int)L; { const int q = nwg / NXCD, r = nwg % NXCD, xcd = wgid % NXCD, off = wgid / NXCD; wgid = (xcd < r ? xcd * (q + 1) : r * (q + 1) + (xcd - r) * q) + off; }
        const int nig = WGM * nN, gid = wgid / nig, fm = gid * WGM, gsz = (nM - fm) < WGM ? (nM - fm) : WGM;
        u.pm = fm + ((wgid % nig) % gsz); u.pn = (wgid % nig) / gsz; return true;
    }
    __device__ __forceinline__ void a_ready(const Unit&) const {}
    __device__ __forceinline__ void done(const Unit&) const {}
};

__device__ __forceinline__ unsigned cvt_pk_bf16(float lo, float hi) { unsigned r; asm volatile("v_cvt_pk_bf16_f32 %0, %1, %2" : "=v"(r) : "v"(lo), "v"(hi)); return r; }
__device__ __forceinline__ float bf_lo(unsigned w) { return __uint_as_float(w << 16); }
__device__ __forceinline__ float bf_hi(unsigned w) { return __uint_as_float(w & 0xffff0000u); }
__device__ __forceinline__ float sigmoid_f(float x) { return __builtin_amdgcn_rcpf(1.0f + __builtin_amdgcn_exp2f(-1.4426950408889634f * x)); }
template <int MODE> struct EpiT {
    static constexpr bool PERM = true, AFTER_DRAIN = false;
    bf16_t* O; int ldc; const bf16_t* P; int qtile; float qscale; float* NRM; const float* RS;
    __device__ __forceinline__ void operator()(const f32x4 (&acc)[2][2][4][2], const Unit& u, int wr, int wc, int fr, int fq) const {
        const int row0 = u.pm * BM + wr * 64 + fr; const int col0 = u.pn * BM + wc * 32 + 8 * fq;
        const float sc = (MODE == 2 && u.pn == qtile) ? qscale : 1.f;
#pragma unroll
        for (int ai = 0; ai < 2; ++ai)
#pragma unroll
            for (int m = 0; m < 4; ++m) { const size_t off = (size_t)(row0 + ai * HALF + m * 16) * ldc + col0; const float rs = (MODE != 0) ? RS[row0 + ai * HALF + m * 16] : 1.f;
#pragma unroll
                for (int bj = 0; bj < 2; ++bj) { f32x4 v0 = acc[ai][bj][m][0], v1 = acc[ai][bj][m][1];
                    if (MODE != 0) { v0 = v0 * rs; v1 = v1 * rs; }
                    if (MODE == 1) {
#pragma unroll
                        for (int e = 0; e < 4; ++e) { const float a = fmaxf(v0[e], 0.f), b = fmaxf(v1[e], 0.f); v0[e] = a * a; v1[e] = b * b; } }
                    if (MODE == 2) { v0 = v0 * sc; v1 = v1 * sc; }
                    if (MODE == 3) { const u32x4 pw = *(const u32x4*)(P + off + bj * HALF);
                        v0[0] = bf_lo(pw.x) * sigmoid_f(v0[0]); v0[1] = bf_hi(pw.x) * sigmoid_f(v0[1]); v0[2] = bf_lo(pw.y) * sigmoid_f(v0[2]); v0[3] = bf_hi(pw.y) * sigmoid_f(v0[3]);
                        v1[0] = bf_lo(pw.z) * sigmoid_f(v1[0]); v1[1] = bf_hi(pw.z) * sigmoid_f(v1[1]); v1[2] = bf_lo(pw.w) * sigmoid_f(v1[2]); v1[3] = bf_hi(pw.w) * sigmoid_f(v1[3]); }
                    u32x4 w; w.x = cvt_pk_bf16(v0[0], v0[1]); w.y = cvt_pk_bf16(v0[2], v0[3]); w.z = cvt_pk_bf16(v1[0], v1[1]); w.w = cvt_pk_bf16(v1[2], v1[3]);
                    *(u32x4*)(O + off + bj * HALF) = w; } }
        if (MODE == 2) { if (u.pn == qtile || u.pn == qtile + 1) {
#pragma unroll
            for (int ai = 0; ai < 2; ++ai)
#pragma unroll
                for (int bj = 0; bj < 2; ++bj) { float mx = 0.f;
#pragma unroll
                    for (int m = 0; m < 4; ++m) { const float rs = RS[row0 + ai * HALF + m * 16] * sc; const f32x4 v0 = acc[ai][bj][m][0] * rs, v1 = acc[ai][bj][m][1] * rs;
                        float ss = ((v0[0] * v0[0] + v0[1] * v0[1]) + (v0[2] * v0[2] + v0[3] * v0[3])) + ((v1[0] * v1[0] + v1[1] * v1[1]) + (v1[2] * v1[2] + v1[3] * v1[3]));
                        ss += __shfl_xor(ss, 16); ss += __shfl_xor(ss, 32); mx = fmaxf(mx, ss); }
                    mx = fmaxf(mx, __shfl_xor(mx, 1)); mx = fmaxf(mx, __shfl_xor(mx, 2)); mx = fmaxf(mx, __shfl_xor(mx, 4)); mx = fmaxf(mx, __shfl_xor(mx, 8));
                    if (fr == 0 && fq == 0) NRM[(((u.pn - qtile) * 2 + (wc & 1)) * 512 + (u.pm * 4 + ai * 2 + wr)) * 4 + bj * 2 + (wc >> 1)] = mx; } } }
    }
};

template <class Epi, class Sched, bool ALIGN_EPI = false, bool SP2 = false>
__device__ __forceinline__ void gemm_phase(PG8_LAS unsigned char* lds, const Gemm g, const Sched& S, const Epi& E, int tid_in) {
    int tid_raw_ = tid_in; asm volatile("" : "+v"(tid_raw_));
    const int tid = tid_raw_, wid = __builtin_amdgcn_readfirstlane(tid >> 6), lane = tid & 63, wr = wid >> 2, wc = wid & 3, fr = lane & 15, fq = lane >> 4;
    const int K = g.K, nt = K / BK;
    unsigned voffA[2], voffB[2];
#pragma unroll
    for (int i = 0; i < 2; ++i) { int R, C; stage_rc(tid * 16 + i * 8192, R, C); const int Rb = Epi::PERM ? ((R & ~31) + perm32(R & 31)) : R;
        voffA[i] = (unsigned)(R * K + C) * 2u; voffB[i] = (unsigned)(Rb * K + C) * 2u; }
    const size_t kstep = (size_t)(BK * 2);
    const size_t hstep = (size_t)HALF * K * 2;
    const size_t tstep = 2 * hstep;
    const unsigned ldsw = (unsigned)wid * 1024u;
    const int aoff = lds_byte(wr * 64 + fr, fq * 8), boff = lds_byte(wc * 32 + fr, fq * 8);
#define PG8_SA(b, h) (((b) * 2 + (h)) * HTB)
#define PG8_SB(b, h) ((4 + (b) * 2 + (h)) * HTB)
#define PG8_STAGE(bufoff, gbase, voff) do { _Pragma("unroll") for (int _i = 0; _i < 2; ++_i) \
        __builtin_amdgcn_global_load_lds((const unsigned*)((const char*)(gbase) + (voff)[_i]), (PG8_LAS unsigned*)(lds + (bufoff) + ldsw + _i * 8192), 16, 0, 0); } while (0)
#define PG8_LDA(dst, b, h) do { _Pragma("unroll") for (int m = 0; m < 4; ++m) _Pragma("unroll") for (int k = 0; k < 2; ++k) dst[m][k] = *(const PG8_LAS bf16x8*)(lds + PG8_SA(b, h) + aoff + m * 2048 + k * 1024); } while (0)
#define PG8_LDB(dst, b, h) do { _Pragma("unroll") for (int n = 0; n < 2; ++n) _Pragma("unroll") for (int k = 0; k < 2; ++k) dst[n][k] = *(const PG8_LAS bf16x8*)(lds + PG8_SB(b, h) + boff + n * 2048 + k * 1024); } while (0)
#define PG8_MMA(ai, bj, At, Bt) do { __builtin_amdgcn_s_setprio(1); _Pragma("unroll") for (int m = 0; m < 4; ++m) _Pragma("unroll") for (int n = 0; n < 2; ++n) _Pragma("unroll") for (int k = 0; k < 2; ++k) \
        acc[ai][bj][m][n] = __builtin_amdgcn_mfma_f32_16x16x32_bf16(Bt[n][k], At[m][k], acc[ai][bj][m][n], 0, 0, 0); __builtin_amdgcn_s_setprio(0); } while (0)
#define PG8_WAIT_V(n) asm volatile("s_waitcnt vmcnt(" #n ")" ::: "memory")
#define PG8_WAIT_L(n) asm volatile("s_waitcnt lgkmcnt(" #n ")" ::: "memory")
#define PG8_BAR __builtin_amdgcn_s_barrier()
#define PG8_SCHED __builtin_amdgcn_sched_barrier(0)
    Unit cur, nxt; int ui = 0;
    if (!S.next(0, cur)) return;
    f32x4 acc[2][2][4][2];
#pragma unroll
    for (int a = 0; a < 2; ++a)
#pragma unroll
        for (int b = 0; b < 2; ++b)
#pragma unroll
            for (int m = 0; m < 4; ++m)
#pragma unroll
                for (int n = 0; n < 2; ++n) acc[a][b][m][n] = (f32x4){0.f, 0.f, 0.f, 0.f};
    bf16x8 At[4][2], B0[2][2], B1[2][2];
    const char* cA = (const char*)g.A + (size_t)cur.pm * tstep; const char* cB = (const char*)g.Bt + (size_t)cur.pn * tstep;
    S.a_ready(cur);
    if constexpr (SP2) {
        PG8_STAGE(PG8_SB(0, 0), cB, voffB); PG8_STAGE(PG8_SB(0, 1), cB + hstep, voffB); PG8_STAGE(PG8_SA(0, 0), cA, voffA); PG8_STAGE(PG8_SA(0, 1), cA + hstep, voffA);
        if (wr == 1) PG8_BAR;
        PG8_WAIT_V(2); PG8_BAR;
        PG8_STAGE(PG8_SB(1, 0), cB + kstep, voffB); PG8_STAGE(PG8_SA(1, 0), cA + kstep, voffA); PG8_STAGE(PG8_SB(1, 1), cB + hstep + kstep, voffB);
        PG8_WAIT_V(6); PG8_BAR;
    } else {
        PG8_STAGE(PG8_SB(0, 0), cB, voffB); PG8_STAGE(PG8_SA(0, 0), cA, voffA); PG8_STAGE(PG8_SB(0, 1), cB + hstep, voffB); PG8_STAGE(PG8_SA(0, 1), cA + hstep, voffA);
        if (wr == 1) PG8_BAR;
        PG8_WAIT_V(4); PG8_BAR;
        PG8_STAGE(PG8_SB(1, 0), cB + kstep, voffB); PG8_STAGE(PG8_SA(1, 0), cA + kstep, voffA); PG8_STAGE(PG8_SB(1, 1), cB + hstep + kstep, voffB);
        PG8_WAIT_V(6); PG8_BAR;
    }
    for (;;) {
        const bool has_next = S.next(ui + 1, nxt);
        const char* nA = has_next ? (const char*)g.A + (size_t)nxt.pm * tstep : cA; const char* nB = has_next ? (const char*)g.Bt + (size_t)nxt.pn * tstep : cB;
        for (int t = 0; t < nt; t += 2) {
            const bool last = (t == nt - 2);
            const char* a1 = cA + (size_t)(t + 1) * kstep;
            const char* a2 = last ? nA : cA + (size_t)(t + 2) * kstep; const char* b2 = last ? nB : cB + (size_t)(t + 2) * kstep;
            const char* a3 = a2 + kstep; const char* b3 = b2 + kstep;
            if (last && has_next) S.a_ready(nxt);
            if constexpr (SP2) {
            PG8_LDB(B0, 0, 0); PG8_LDB(B1, 0, 1); PG8_SCHED; PG8_LDA(At, 0, 0); PG8_STAGE(PG8_SA(1, 1), a1 + hstep, voffA);
            PG8_WAIT_V(8); PG8_WAIT_L(0); PG8_BAR; PG8_MMA(0, 0, At, B0); PG8_MMA(0, 1, At, B1); PG8_BAR; PG8_SCHED;
            PG8_LDA(At, 0, 1); PG8_STAGE(PG8_SB(0, 0), b2, voffB); PG8_STAGE(PG8_SB(0, 1), b2 + hstep, voffB); PG8_STAGE(PG8_SA(0, 0), a2, voffA);
            PG8_WAIT_V(8); PG8_WAIT_L(0); PG8_BAR; PG8_MMA(1, 0, At, B0); PG8_MMA(1, 1, At, B1); PG8_BAR; PG8_SCHED;
            PG8_LDB(B0, 1, 0); PG8_LDB(B1, 1, 1); PG8_SCHED; PG8_LDA(At, 1, 0); PG8_STAGE(PG8_SA(0, 1), a2 + hstep, voffA);
            PG8_WAIT_V(8); PG8_WAIT_L(0); PG8_BAR; PG8_MMA(0, 0, At, B0); PG8_MMA(0, 1, At, B1); PG8_BAR; PG8_SCHED;
            PG8_LDA(At, 1, 1); PG8_STAGE(PG8_SB(1, 0), b3, voffB); PG8_STAGE(PG8_SB(1, 1), b3 + hstep, voffB); PG8_STAGE(PG8_SA(1, 0), a3, voffA);
            PG8_WAIT_V(8); PG8_WAIT_L(0); PG8_BAR; PG8_MMA(1, 0, At, B0); PG8_MMA(1, 1, At, B1); PG8_BAR; PG8_SCHED;
            } else {
            PG8_LDB(B0, 0, 0); PG8_SCHED; PG8_LDA(At, 0, 0); PG8_STAGE(PG8_SA(1, 1), a1 + hstep, voffA);
            PG8_WAIT_L(8); PG8_BAR; PG8_WAIT_L(0); PG8_MMA(0, 0, At, B0); PG8_BAR; PG8_SCHED;
            PG8_LDB(B1, 0, 1); PG8_STAGE(PG8_SB(0, 0), b2, voffB);
            PG8_BAR; PG8_WAIT_L(0); PG8_MMA(0, 1, At, B1); PG8_BAR;
            PG8_LDA(At, 0, 1); PG8_STAGE(PG8_SA(0, 0), a2, voffA);
            PG8_BAR; PG8_WAIT_L(0); PG8_MMA(1, 0, At, B0); PG8_BAR; PG8_SCHED;
            PG8_STAGE(PG8_SB(0, 1), b2 + hstep, voffB);
            PG8_WAIT_V(6); PG8_BAR; PG8_MMA(1, 1, At, B1); PG8_BAR;
            PG8_LDB(B0, 1, 0); PG8_SCHED; PG8_LDA(At, 1, 0); PG8_STAGE(PG8_SA(0, 1), a2 + hstep, voffA);
            PG8_WAIT_L(8); PG8_BAR; PG8_WAIT_L(0); PG8_MMA(0, 0, At, B0); PG8_BAR; PG8_SCHED;
            PG8_LDB(B1, 1, 1); PG8_STAGE(PG8_SB(1, 0), b3, voffB);
            PG8_BAR; PG8_WAIT_L(0); PG8_MMA(0, 1, At, B1); PG8_BAR;
            PG8_LDA(At, 1, 1); PG8_STAGE(PG8_SA(1, 0), a3, voffA);
            PG8_BAR; PG8_WAIT_L(0); PG8_MMA(1, 0, At, B0); PG8_BAR; PG8_SCHED;
            PG8_STAGE(PG8_SB(1, 1), b3 + hstep, voffB);
            PG8_WAIT_V(6); PG8_BAR; PG8_MMA(1, 1, At, B1); PG8_BAR;
            }
        }
        if constexpr (ALIGN_EPI) { if (wr == 0) PG8_BAR; }
        if constexpr (!Epi::AFTER_DRAIN) { E(acc, cur, wr, wc, fr, fq); S.done(cur); }
        if (!has_next) break;
#pragma unroll
        for (int a = 0; a < 2; ++a)
#pragma unroll
            for (int b = 0; b < 2; ++b)
#pragma unroll
                for (int m = 0; m < 4; ++m)
#pragma unroll
                    for (int n = 0; n < 2; ++n) acc[a][b][m][n] = (f32x4){0.f, 0.f, 0.f, 0.f};
        cur = nxt; cA = nA; cB = nB; ++ui;
        if constexpr (ALIGN_EPI) { if (wr == 1) PG8_BAR; }
    }
    PG8_WAIT_V(0);
    if constexpr (!ALIGN_EPI) { if (wr == 0) PG8_BAR; }
    PG8_BAR;
    if constexpr (Epi::AFTER_DRAIN) { E.fused(acc, cur, wr, wc, fr, fq, lds, wid, lane); S.done(cur); }
#undef PG8_SA
#undef PG8_SB
#undef PG8_STAGE
#undef PG8_LDA
#undef PG8_LDB
#undef PG8_MMA
#undef PG8_WAIT_V
#undef PG8_WAIT_L
#undef PG8_BAR
#undef PG8_SCHED
}
}
namespace attn_body {
using bf16=__hip_bfloat16;
using bf16x8=__attribute__((ext_vector_type(8)))short;
using s16x4=__attribute__((ext_vector_type(4)))short;
using f32x16=__attribute__((ext_vector_type(16)))float;
using u32x4=__attribute__((ext_vector_type(4)))unsigned;
using f32x4v=__attribute__((ext_vector_type(4)))float;
constexpr int BATCH=4,NHEAD=4,SEQ=8192,D=64,DM=2304,DMO=1024;
constexpr int NW=8,QBLK=32,QB=QBLK*NW,KVBLK=64,NQB=SEQ/QB;
constexpr int ATTN_PITCH=DM, ATTN_UNIT_ROWS=QB;
__device__ __forceinline__ int crow(int r,int hi){return (r&3)+8*(r>>2)+4*hi;}
#define SBAR() __builtin_amdgcn_sched_barrier(0)
__device__ __forceinline__ void cmask(f32x16&p0,f32x16&p1,int jb,int qrel,int hi){
  const float NEG=-INFINITY; int kb=64*jb+4*hi;
  #pragma unroll
  for(int r=0;r<16;++r){int kv=kb+(r&3)+8*(r>>2); if(kv>qrel)p0[r]=NEG; if(kv+32>qrel)p1[r]=NEG;}
}

constexpr int NSLOT=3, SLOTB=8192;
constexpr int LDS_K=0, LDS_V=NSLOT*SLOTB, LDS_WS=2*NSLOT*SLOTB, LDS_OST=LDS_WS+NW*64*4, LDS_BIAS=LDS_OST+NW*4096, LDS_BYTES=LDS_BIAS+SEQ*4+64;
constexpr float C2=0.125f*1.4426950408889634f;
__device__ __forceinline__ void glds16(const void*gsrc,unsigned lds_dst){unsigned keep;
  asm volatile("s_mov_b32 %0, m0\n\ts_mov_b32 m0, %2\n\ts_nop 0\n\tglobal_load_lds_dwordx4 %1, off\n\ts_mov_b32 m0, %0":"=&s"(keep):"v"(gsrc),"s"(lds_dst):"memory");}
__device__ __forceinline__ float max3f(float a,float b,float c){float r;asm("v_max3_f32 %0, %1, %2, %3":"=v"(r):"v"(a),"v"(b),"v"(c));return r;}
__device__ __forceinline__ float max2f(float a,float b){float r;asm("v_max_f32_e32 %0, %1, %2":"=v"(r):"v"(a),"v"(b));return r;}
__device__ __forceinline__ float fadd_s(float a,float b){float r;asm("v_add_f32_e32 %0, %1, %2":"=v"(r):"v"(a),"v"(b));return r;}
__device__ __forceinline__ float fsub_s(float a,float b){float r;asm("v_sub_f32_e32 %0, %1, %2":"=v"(r):"v"(a),"v"(b));return r;}
typedef float f32x2_t __attribute__((ext_vector_type(2))); typedef __bf16 bf16x2_t __attribute__((ext_vector_type(2)));
__device__ __forceinline__ unsigned cvtpk_s(float lo,float hi){f32x2_t v={lo,hi};bf16x2_t b=__builtin_convertvector(v,bf16x2_t);return __builtin_bit_cast(unsigned,b);}
#define WAIT_BAR(N) asm volatile("s_waitcnt vmcnt(" #N ") lgkmcnt(0)\n\ts_barrier":::"memory")

__device__ __forceinline__ void qkt(f32x16&p0,f32x16&p1,const char*Kslot,const bf16x8*qr,int r32,int hi){
  const char*kb=Kslot+hi*1024+r32*16;
  #pragma unroll
  for(int d0=0;d0<4;++d0){
    const bf16x8 b0=*reinterpret_cast<const bf16x8*>(kb+d0*2048);
    const bf16x8 b1=*reinterpret_cast<const bf16x8*>(kb+d0*2048+512);
    {p0=__builtin_amdgcn_mfma_f32_32x32x16_bf16(b0,qr[d0],p0,0,0,0);p1=__builtin_amdgcn_mfma_f32_32x32x16_bf16(b1,qr[d0],p1,0,0,0);}}
}
typedef __attribute__((address_space(3))) const char* lds_cptr;
typedef short v4i16_t __attribute__((ext_vector_type(4)));
__device__ __forceinline__ void kload8(bf16x8*kf,lds_cptr kp){
  kf[0]=*(const __attribute__((address_space(3))) bf16x8*)(kp);      kf[1]=*(const __attribute__((address_space(3))) bf16x8*)(kp+512);
  kf[2]=*(const __attribute__((address_space(3))) bf16x8*)(kp+2048); kf[3]=*(const __attribute__((address_space(3))) bf16x8*)(kp+2560);
  kf[4]=*(const __attribute__((address_space(3))) bf16x8*)(kp+4096); kf[5]=*(const __attribute__((address_space(3))) bf16x8*)(kp+4608);
  kf[6]=*(const __attribute__((address_space(3))) bf16x8*)(kp+6144); kf[7]=*(const __attribute__((address_space(3))) bf16x8*)(kp+6656);
}
__device__ __forceinline__ void kload2(bf16x8*kf,lds_cptr kp,int j){ kf[2*j]=*(const __attribute__((address_space(3))) bf16x8*)(kp+j*2048); kf[2*j+1]=*(const __attribute__((address_space(3))) bf16x8*)(kp+j*2048+512); }
__device__ __forceinline__ s16x4 vtr(lds_cptr p){ return __builtin_bit_cast(s16x4,__builtin_amdgcn_ds_read_tr16_b64_v4i16((__attribute__((address_space(3))) v4i16_t*)p)); }
__device__ __forceinline__ float rowmax(const f32x16&p0,const f32x16&p1){
  float a=max3f(p0[0],p0[1],p1[0]),b=max3f(p0[2],p0[3],p1[1]);a=max3f(a,p1[2],p1[3]);
  #pragma unroll
  for(int r=4;r<16;r+=4){a=max3f(a,p0[r],p0[r+1]);b=max3f(b,p0[r+2],p0[r+3]);a=max3f(a,p1[r],p1[r+1]);b=max3f(b,p1[r+2],p1[r+3]);}
  const float m=max2f(a,b);
  auto rr=__builtin_amdgcn_permlane32_swap(__float_as_uint(m),__float_as_uint(m),false,false);
  return max2f(__uint_as_float(rr[0]),__uint_as_float(rr[1]));
}
__device__ __forceinline__ void pv(f32x16*o,int vb,bf16x8 pa0,bf16x8 pa1,bf16x8 pa2,bf16x8 pa3){
  #pragma unroll
  for(int d0=0;d0<2;++d0){s16x4 lo[4],hi[4];
    #pragma unroll
    for(int ks=0;ks<4;++ks){
      asm volatile("ds_read_b64_tr_b16 %0,%1 offset:%c2":"=&v"(lo[ks]):"v"(vb),"i"(d0*4096+ks*1024):"memory");
      asm volatile("ds_read_b64_tr_b16 %0,%1 offset:%c2":"=&v"(hi[ks]):"v"(vb),"i"(d0*4096+ks*1024+512):"memory");}
    asm volatile("s_waitcnt lgkmcnt(0)":::"memory");SBAR();
    #define PK(k) (bf16x8){lo[k][0],lo[k][1],lo[k][2],lo[k][3],hi[k][0],hi[k][1],hi[k][2],hi[k][3]}
    o[d0]=__builtin_amdgcn_mfma_f32_32x32x16_bf16(pa0,PK(0),o[d0],0,0,0);
    o[d0]=__builtin_amdgcn_mfma_f32_32x32x16_bf16(pa1,PK(1),o[d0],0,0,0);
    o[d0]=__builtin_amdgcn_mfma_f32_32x32x16_bf16(pa2,PK(2),o[d0],0,0,0);
    o[d0]=__builtin_amdgcn_mfma_f32_32x32x16_bf16(pa3,PK(3),o[d0],0,0,0);
    #undef PK
  }
}

#ifndef ATTN_STORE16
#define ATTN_STORE16(p,v) (*(u32x4*)(p)=(v))
#endif
template<int THRL> __device__ __forceinline__ void attn_unit(int b,int h,int qb,const bf16*Q,const bf16*__restrict__ K,const bf16*__restrict__ V,bf16*O,const float*__restrict__ CB,const float*__restrict__ NRM,char*shm,int tid_in){
  int tid_raw_=tid_in; asm volatile("":"+v"(tid_raw_));
  const int tid=tid_raw_,lane=tid&63,r32=lane&31,hi=lane>>5; const int wid=__builtin_amdgcn_readfirstlane(tid>>6);
  const long rowbase=(long)b*SEQ; const int q0=qb*QB;
  const float cref=CB[q0];
  const bf16*Qw=Q+(rowbase+q0+wid*QBLK)*DM+h*D;
  bf16x8 qr[4];
  #pragma unroll
  for(int d0=0;d0<4;++d0)qr[d0]=*reinterpret_cast<const bf16x8*>(&Qw[(long)r32*DM+d0*16+hi*8]);
  {
    if(tid<128){ const int t=tid; bool skip=false;
      if(t<(q0+QB)/KVBLK-4){ const int gq=(b*SEQ+q0)>>6; float q2=0.f;
        _Pragma("unroll") for(int i=0;i<4;++i) q2=fmaxf(q2,NRM[(0*512+gq+i)*4+h]+NRM[(1*512+gq+i)*4+h]);
        float kb2=0.f; _Pragma("unroll") for(int i=0;i<4;++i) kb2=fmaxf(kb2,NRM[(2*512+gq+i)*4+h]+NRM[(3*512+gq+i)*4+h]);
        const int gk=(b*SEQ>>6)+t; const float k2=NRM[(2*512+gk)*4+h]+NRM[(3*512+gk)*4+h];
        skip=(cref-CB[64*t+63])+1.02f*sqrtf(q2)*(sqrtf(k2)+sqrtf(kb2))<-160.f; }
      const unsigned long long mk=__ballot(skip); if(lane==0)((__attribute__((address_space(3))) unsigned long long*)((lds_cptr)shm+LDS_BIAS+SEQ*4))[wid]=mk;
      if(tid==0){ const int gq=(b*SEQ+q0)>>6; float q2=0.f,kb2=0.f;
        _Pragma("unroll") for(int i=0;i<4;++i){ q2=fmaxf(q2,NRM[(0*512+gq+i)*4+h]+NRM[(1*512+gq+i)*4+h]); kb2=fmaxf(kb2,NRM[(2*512+gq+i)*4+h]+NRM[(3*512+gq+i)*4+h]); }
        ((__attribute__((address_space(3))) float*)((lds_cptr)shm+LDS_BIAS+SEQ*4))[4]=1.02f*sqrtf(q2*kb2); } }
    asm volatile("s_waitcnt vmcnt(0) lgkmcnt(0)\n\ts_barrier":::"memory"); }
  int T0;
  { const __attribute__((address_space(3))) unsigned long long* mkp=(const __attribute__((address_space(3))) unsigned long long*)((lds_cptr)shm+LDS_BIAS+SEQ*4);
    const unsigned long long m0=mkp[0],m1=mkp[1]; const int n0=(~m0)?__builtin_ctzll(~m0):64, n1=(~m1)?__builtin_ctzll(~m1):64;
    T0=(n0<64?n0:64+n1); const int ntall=(q0+QB)/KVBLK; T0&=~1; if(T0>ntall-4)T0=ntall-4; T0=__builtin_amdgcn_readfirstlane(T0); }
  { typedef __attribute__((address_space(3))) float lds_f; lds_f*btw=(lds_f*)((lds_cptr)shm+LDS_BIAS);
    for(int i=64*T0+tid;i<q0+QB;i+=NW*64) btw[i]=cref-CB[i];
    asm volatile("s_waitcnt vmcnt(0) lgkmcnt(0)\n\ts_barrier":::"memory"); }
  const bf16*Kh=K+(rowbase+(long)T0*KVBLK)*DM+h*D,*Vh=V+(rowbase+(long)T0*KVBLK)*DM+h*D;
  const unsigned lds0=(unsigned)(uintptr_t)shm;
  float*wsf=(float*)(shm+LDS_WS)+wid*64;
  const bf16*ksrc=Kh+(long)lane*DM+wid*8;
  const bf16*vsrc=Vh+(long)(16*(wid&3)+(lane>>2))*DM+(wid>>2)*32+(lane&3)*8;
  const unsigned kdst=lds0+LDS_K+wid*1024, vdst=lds0+LDS_V+wid*1024;
  #define DMA_K(t,slot) glds16(ksrc+(long)(t)*KVBLK*DM,(unsigned)__builtin_amdgcn_readfirstlane(kdst+(slot)))
  #define DMA_V(t,slot) glds16(vsrc+(long)(t)*KVBLK*DM,(unsigned)__builtin_amdgcn_readfirstlane(vdst+(slot)))
  const int vb0=(int)(lds0+LDS_V)+((lane>>4)&1)*32+(lane&3)*8+(4*hi+((lane&15)>>2))*64;
  const char*Kbase=shm+LDS_K; bf16x8 kf[8];
  const lds_cptr shm3=(lds_cptr)shm; const lds_cptr kp0=shm3+LDS_K+hi*1024+r32*16; const lds_cptr vp0=shm3+LDS_V+((lane>>4)&1)*32+(lane&3)*8+(4*hi+((lane&15)>>2))*64;
  const int NT=(q0+QB)/KVBLK-T0;
  DMA_K(0,0);DMA_V(0,0);DMA_K(1,SLOTB);
  typedef __attribute__((address_space(3))) const float lds_cf; typedef __attribute__((address_space(3))) const f32x4v lds_cf4;
  lds_cf*bt=(lds_cf*)((lds_cptr)shm+LDS_BIAS); lds_cf4*bt4=(lds_cf4*)((lds_cptr)shm+LDS_BIAS)+hi+16*T0;
  float mhat=bt[q0+wid*QBLK+r32]-((lds_cf*)((lds_cptr)shm+LDS_BIAS+SEQ*4))[4],l_reg=0.f;   f32x16 o[2];o[0]=f32x16{};o[1]=f32x16{};
  #define BINIT(P0,P1,t) do{ _Pragma("unroll") for(int g_=0;g_<4;++g_){ const f32x4v b0_=bt4[16*(t)+2*g_], b1_=bt4[16*(t)+8+2*g_]; \
      P0[4*g_]=b0_[0]-mhat;P0[4*g_+1]=b0_[1]-mhat;P0[4*g_+2]=b0_[2]-mhat;P0[4*g_+3]=b0_[3]-mhat; P1[4*g_]=b1_[0]-mhat;P1[4*g_+1]=b1_[1]-mhat;P1[4*g_+2]=b1_[2]-mhat;P1[4*g_+3]=b1_[3]-mhat; } }while(0)
  const int qrel=wid*QBLK+r32;
  #define CMASK(P0,P1,t) do{int jb_=(t)-(NT-4); if(jb_>=0)cmask(P0,P1,jb_,qrel,hi);}while(0)
  bool resc=false;
  #define START(P0,P1) do{ const float rm=rowmax(P0,P1); resc=false; \
    if(__any(rm>(float)THRL)){ const float dl=max2f(rm,0.f); mhat=fadd_s(mhat,dl); \
      _Pragma("unroll") for(int r=0;r<16;++r){P0[r]=fsub_s(P0[r],dl);P1[r]=fsub_s(P1[r],dl);} } \
    _Pragma("unroll") for(int r=0;r<16;++r)P0[r]=__builtin_amdgcn_exp2f(P0[r]); }while(0)
  #define RESC() do{ if(resc){ asm volatile("s_waitcnt lgkmcnt(0)":::"memory"); \
      _Pragma("unroll") for(int d_=0;d_<2;++d_) _Pragma("unroll") for(int r=0;r<16;++r)o[d_][r]*=wsf[crow(r,hi)]; } }while(0)
  f32x16 pA0,pA1,pB0,pB1;
  int sl_prev=0,sl_cur=0,sl_next=SLOTB;
  #define ROT() do{sl_prev=sl_cur;sl_cur=sl_next;sl_next=(sl_next==(NSLOT-1)*SLOTB)?0:sl_next+SLOTB;}while(0)
  DMA_K(2,2*SLOTB);
  WAIT_BAR(3);
  BINIT(pA0,pA1,0);qkt(pA0,pA1,Kbase,qr,r32,hi);asm volatile("s_nop 15\n\ts_nop 7":"+v"(pA0),"+v"(pA1));CMASK(pA0,pA1,0);
  START(pA0,pA1);
  _Pragma("unroll") for(int r=0;r<16;++r)pA1[r]=__builtin_amdgcn_exp2f(pA1[r]);
  WAIT_BAR(0);
  DMA_K(3,0);DMA_V(1,SLOTB);
  ROT();
  kload8(kf,kp0+sl_cur);
  WAIT_BAR(2);
  s16x4 vlo[8],vhi[8]; u32x4 pw0,pw1,pw2,pw3;
  #define PKW(P,B) cvtpk_s(P[B],P[B+1])
  #define PAF(k) __builtin_bit_cast(bf16x8,pw##k)
  #define VFR(i) (bf16x8){vlo[i][0],vlo[i][1],vlo[i][2],vlo[i][3],vhi[i][0],vhi[i][1],vhi[i][2],vhi[i][3]}
  #define PIN(x) asm volatile("":"+v"(x))
  #define MX3(a,b,c) __builtin_fmaxf(__builtin_fmaxf((a),(b)),(c))
  #define GAPA(MF,A0,A1,A2,A3,W0,W1,PW) do{ MF; sacc+=A0; sacc+=A1; sacc+=A2; sacc+=A3; PIN(sacc); W0; W1; PIN(PW); SBAR(); }while(0)
  #define EX(v) __builtin_amdgcn_exp2f(v)
  #define GAPB(MF,X,B) do{ MF; X[B]=EX(X[B]); X[B+1]=EX(X[B+1]); X[B+2]=EX(X[B+2]); X[B+3]=EX(X[B+3]); PIN(X); SBAR(); }while(0)
  #define VRD(i) do{ vlo[i]=vtr(vp_+(((i)>>2)*4096+((i)&3)*1024)); vhi[i]=vtr(vp_+(((i)>>2)*4096+((i)&3)*1024+512)); }while(0)
  #define KRD(G,j) do{ if(G){ kload2(kf,kp0+sl_next,j); SBAR(); } }while(0)
  #define STEP(C0,C1,P0,P1,t,GK,GV,GL) do{ SBAR(); BINIT(C0,C1,t); SBAR(); \
    const lds_cptr vp_=vp0+sl_prev; \
    VRD(0); SBAR(); float sacc=(P0[0]+P0[1]); \
    GAPA(C0=__builtin_amdgcn_mfma_f32_32x32x16_bf16(kf[0],qr[0],C0,0,0,0), P0[2],P0[3],P0[4],P0[5],     pw0[0]=PKW(P0,0), pw0[1]=PKW(P0,2), pw0); \
    VRD(4); SBAR(); GAPA(C1=__builtin_amdgcn_mfma_f32_32x32x16_bf16(kf[1],qr[0],C1,0,0,0), P0[6],P0[7],P0[8],P0[9],     pw0[2]=PKW(P0,4), pw0[3]=PKW(P0,6), pw0); \
    VRD(1); SBAR(); GAPA(C0=__builtin_amdgcn_mfma_f32_32x32x16_bf16(kf[2],qr[1],C0,0,0,0),   P0[10],P0[11],P0[12],P0[13], pw1[0]=PKW(P0,8), pw1[1]=PKW(P0,10), pw1); \
    VRD(5); SBAR(); GAPA(C1=__builtin_amdgcn_mfma_f32_32x32x16_bf16(kf[3],qr[1],C1,0,0,0),   P0[14],P0[15],P1[0],P1[1],   pw1[2]=PKW(P0,12),pw1[3]=PKW(P0,14), pw1); \
    VRD(2); SBAR(); GAPA(C0=__builtin_amdgcn_mfma_f32_32x32x16_bf16(kf[4],qr[2],C0,0,0,0),   P1[2],P1[3],P1[4],P1[5],     pw2[0]=PKW(P1,0), pw2[1]=PKW(P1,2), pw2); \
    VRD(6); SBAR(); GAPA(C1=__builtin_amdgcn_mfma_f32_32x32x16_bf16(kf[5],qr[2],C1,0,0,0),   P1[6],P1[7],P1[8],P1[9],     pw2[2]=PKW(P1,4), pw2[3]=PKW(P1,6), pw2); \
    VRD(3); SBAR(); GAPA(C0=__builtin_amdgcn_mfma_f32_32x32x16_bf16(kf[6],qr[3],C0,0,0,0),   P1[10],P1[11],P1[12],P1[13], pw3[0]=PKW(P1,8), pw3[1]=PKW(P1,10), pw3); \
    VRD(7); SBAR(); GAPA(C1=__builtin_amdgcn_mfma_f32_32x32x16_bf16(kf[7],qr[3],C1,0,0,0),   P1[14],P1[15],0.f,0.f,       pw3[2]=PKW(P1,12),pw3[3]=PKW(P1,14), pw3); \
    l_reg+=sacc; \
    if(GK){DMA_K((t)+3,sl_cur);} if(GV){DMA_V((t)+1,sl_next);} \
    CMASK(C0,C1,t); \
    { float a=MX3(C0[0],C0[1],C1[0]),b=MX3(C0[2],C0[3],C1[1]); a=MX3(a,C1[2],C1[3]); \
      _Pragma("unroll") for(int r=4;r<16;r+=4){a=MX3(a,C0[r],C0[r+1]);b=MX3(b,C0[r+2],C0[r+3]);a=MX3(a,C1[r],C1[r+1]);b=MX3(b,C1[r+2],C1[r+3]);} \
      float rm=__builtin_fmaxf(a,b); { auto rr=__builtin_amdgcn_permlane32_swap(__float_as_uint(rm),__float_as_uint(rm),false,false); rm=__builtin_fmaxf(__uint_as_float(rr[0]),__uint_as_float(rr[1])); } \
      resc=false; \
      if(__builtin_expect(__any(rm>(float)THRL),0)){ const float dl=__builtin_fmaxf(rm,0.f); mhat+=dl; \
        _Pragma("unroll") for(int r=0;r<16;++r){C0[r]-=dl;C1[r]-=dl;} \
        const float f=__builtin_amdgcn_exp2f(-dl); l_reg*=f; if(hi==0)wsf[r32]=f; resc=true; } } \
    SBAR(); \
    GAPB(o[0]=__builtin_amdgcn_mfma_f32_32x32x16_bf16(PAF(0),VFR(0),o[0],0,0,0), C0,0); \
    GAPB(o[1]=__builtin_amdgcn_mfma_f32_32x32x16_bf16(PAF(0),VFR(4),o[1],0,0,0), C0,4); \
    KRD(GL,0); GAPB(o[0]=__builtin_amdgcn_mfma_f32_32x32x16_bf16(PAF(1),VFR(1),o[0],0,0,0), C0,8); \
    KRD(GL,1); GAPB(o[1]=__builtin_amdgcn_mfma_f32_32x32x16_bf16(PAF(1),VFR(5),o[1],0,0,0), C0,12); \
    KRD(GL,2); GAPB(o[0]=__builtin_amdgcn_mfma_f32_32x32x16_bf16(PAF(2),VFR(2),o[0],0,0,0), C1,0); \
    KRD(GL,3); GAPB(o[1]=__builtin_amdgcn_mfma_f32_32x32x16_bf16(PAF(2),VFR(6),o[1],0,0,0), C1,4); \
    GAPB(o[0]=__builtin_amdgcn_mfma_f32_32x32x16_bf16(PAF(3),VFR(3),o[0],0,0,0), C1,8); \
    GAPB(o[1]=__builtin_amdgcn_mfma_f32_32x32x16_bf16(PAF(3),VFR(7),o[1],0,0,0), C1,12); \
    }while(0)
  int t=1;
  #undef CMASK
  #define CMASK(P0,P1,t) do{}while(0)
  for(;t+5<NT;t+=2){
    STEP(pB0,pB1,pA0,pA1,t,true,true,true);     WAIT_BAR(2); RESC(); ROT();
    STEP(pA0,pA1,pB0,pB1,t+1,true,true,true);   WAIT_BAR(2); RESC(); ROT();
  }
  #undef CMASK
  #define CMASK(P0,P1,t) do{int jb_=(t)-(NT-4); if(jb_>=0)cmask(P0,P1,jb_,qrel,hi);}while(0)
  #define ENDW(tt) do{ if((tt)+3<NT){WAIT_BAR(2);} else if((tt)+2<NT){WAIT_BAR(1);} else {WAIT_BAR(0);} }while(0)
  for(;t+1<NT;t+=2){
    STEP(pB0,pB1,pA0,pA1,t,(t+3<NT),(t+1<NT),(t+1<NT));       ENDW(t);   RESC(); ROT();
    STEP(pA0,pA1,pB0,pB1,t+1,(t+4<NT),(t+2<NT),(t+2<NT));     ENDW(t+1); RESC(); ROT();
  }
  STEP(pB0,pB1,pA0,pA1,NT-1,false,false,false); RESC();
  { float sacc=pB0[0]+pB0[1]; _Pragma("unroll") for(int r=2;r<16;++r)sacc+=pB0[r]; _Pragma("unroll") for(int r=0;r<16;++r)sacc+=pB1[r]; l_reg+=sacc;
    pw0=(u32x4){PKW(pB0,0),PKW(pB0,2),PKW(pB0,4),PKW(pB0,6)};pw1=(u32x4){PKW(pB0,8),PKW(pB0,10),PKW(pB0,12),PKW(pB0,14)};pw2=(u32x4){PKW(pB1,0),PKW(pB1,2),PKW(pB1,4),PKW(pB1,6)};pw3=(u32x4){PKW(pB1,8),PKW(pB1,10),PKW(pB1,12),PKW(pB1,14)};
    SBAR(); pv(o,vb0+sl_cur,PAF(0),PAF(1),PAF(2),PAF(3)); }
  #undef PKW
  #undef PAF
  #undef VFR
  #undef PIN
  #undef MX3
  #undef GAPA
  #undef GAPB
  #undef EX
  #undef VRD
  #undef KRD
  #undef STEP
  #undef ENDW
  {auto rr=__builtin_amdgcn_permlane32_swap(__float_as_uint(l_reg),__float_as_uint(l_reg),false,false);l_reg=__uint_as_float(rr[0])+__uint_as_float(rr[1]);}
  if(hi==0)wsf[32+r32]=l_reg;asm volatile("s_waitcnt lgkmcnt(0)":::"memory");
  float rli[16];
  #pragma unroll
  for(int r=0;r<16;++r)rli[r]=__builtin_amdgcn_rcpf(wsf[32+crow(r,hi)]);
  bf16*Ow=O+(rowbase+q0+wid*QBLK)*DMO+h*D;
  { bf16*stg=(bf16*)(shm+LDS_OST)+wid*2048;
    #pragma unroll
    for(int r=0;r<16;++r){const int orow=crow(r,hi);
      #pragma unroll
      for(int d0=0;d0<2;++d0)stg[orow*64+d0*32+r32]=__float2bfloat16(o[d0][r]*rli[r]);}
    asm volatile("s_waitcnt lgkmcnt(0)":::"memory");
    #pragma unroll
    for(int i=0;i<4;++i){const int row=i*8+(lane>>3),ch=lane&7; const u32x4 v=*(const u32x4*)(stg+row*64+ch*8); ATTN_STORE16(Ow+(long)row*DMO+ch*8,v);} }
  asm volatile("s_waitcnt lgkmcnt(0)\n\ts_barrier":::"memory");
  #undef DMA_K
  #undef DMA_V
  #undef CMASK
  #undef START
  #undef RESC
  #undef ROT
  #undef BINIT
}
constexpr int ATTN_LDS_BYTES=LDS_BYTES;
struct AttnTensors { const bf16* Q; const bf16* K; const bf16* V; bf16* O; const float* CB; const float* NRM; };
struct AttnUnit { int bh; int qb; };
struct StaticOrder {
  int vcu;
  __device__ __forceinline__ explicit StaticOrder(int grid,int block):vcu((block%8)*(grid/8)+block/8){}
  __device__ __forceinline__ bool next(int i,AttnUnit&u)const{ if(i>=2)return false; const int s=vcu&15; u.bh=vcu>>4; u.qb=(i==0)?31-s:s; return true; }
  __device__ __forceinline__ void a_ready(const AttnUnit&)const{}
  __device__ __forceinline__ void done(const AttnUnit&)const{}
};
template<class Sched,int THRL=8> __device__ __forceinline__ void attn_phase(char*lds,const AttnTensors&T,const Sched&S,int tid_in){
  AttnUnit u;
  for(int i=0;S.next(i,u);++i){ S.a_ready(u); attn_unit<THRL>(u.bh/NHEAD,u.bh%NHEAD,u.qb,T.Q,T.K,T.V,T.O,T.CB+(long)u.bh*SEQ,T.NRM,lds,tid_in); S.done(u); }
}
#undef SBAR
#undef WAIT_BAR
}
namespace cg = cooperative_groups;
constexpr int NWAVES = 8;
constexpr int BATCH = 4, SEQ = 8192, DM = 1024, M = BATCH * SEQ, DEPTH = 4, DIN = 2308, ZP = 2304, FF = 4096, DPLE = 256;
constexpr float EPS = 1e-6f;
constexpr float LOG2E = 1.4426950408889634f;
constexpr size_t MiB = 1u << 20;
constexpr size_t WS_BAR = 65536, WS_CTL_BYTES = 128 * 1024;
constexpr size_t WS_LF = 1 * MiB;
constexpr size_t WS_CB = 1 * MiB + 512 * 1024;
constexpr size_t WS_NRM = 3 * MiB;
constexpr size_t WS_RS = 3 * MiB + 65536;
constexpr size_t WS_WF = 2 * MiB;
constexpr size_t WS_W = 4 * MiB, W_STRIDE = 25 * MiB;
constexpr size_t WO_IN = 0, WO_O = 4 * MiB + 512 * 1024, WO_UP = WO_O + 2 * MiB, WO_DN = WO_UP + 8 * MiB, WO_G = WO_DN + 8 * MiB, WO_P = WO_G + 2 * MiB;
static_assert(WO_P + 512 * 1024 == W_STRIDE, "weights map");
constexpr size_t WS_XN = 104 * MiB;
constexpr size_t WS_G = 168 * MiB;
constexpr size_t WS_R = 232 * MiB;
constexpr size_t WS_Z = WS_R, WS_MC = WS_R + 144 * MiB, WS_UP = WS_R, WS_PROJ = WS_R, WS_PBF = WS_R + 256 * MiB;
constexpr size_t WS_END = WS_R + 256 * MiB + 16 * MiB;
constexpr int LDS_BYTES = 147456;

#define GAS __attribute__((address_space(1)))
#define LAS __attribute__((address_space(3)))
typedef unsigned short bf16;
typedef unsigned v4u __attribute__((ext_vector_type(4)));
typedef unsigned v2u __attribute__((ext_vector_type(2)));
typedef float f32x4 __attribute__((ext_vector_type(4)));
#define LDS_WAIT() asm volatile("s_waitcnt lgkmcnt(0)" ::: "memory")
typedef float f32x2_pk __attribute__((ext_vector_type(2))); typedef __bf16 bf16x2_pk __attribute__((ext_vector_type(2)));
__device__ __forceinline__ unsigned pk2(float lo, float hi) { const f32x2_pk v = {lo, hi}; return __builtin_bit_cast(unsigned, __builtin_convertvector(v, bf16x2_pk)); }
__device__ __forceinline__ unsigned f2bf(float f) { return pk2(f, 0.f) & 0xffffu; }
__device__ __forceinline__ float bflo(unsigned w) { return __uint_as_float(w << 16); }
__device__ __forceinline__ float bfhi(unsigned w) { return __uint_as_float(w & 0xffff0000u); }
__device__ __forceinline__ float bf1(bf16 v) { return __uint_as_float((unsigned)v << 16); }
__device__ __forceinline__ float sigm(float x) { return __builtin_amdgcn_rcpf(1.0f + __expf(-x)); }
__device__ __forceinline__ float wave_sum(float v) {
#pragma unroll
    for (int o = 1; o < 64; o <<= 1) v += __shfl_xor(v, o);
    return v;
}

__device__ __forceinline__ void tr_store(LAS float* scr, bf16* WT, int K, int drow0, int k0, int lane) {
    LDS_WAIT(); asm volatile("" ::: "memory");
    const int c = lane & 7;
#pragma unroll
    for (int j = 0; j < 4; ++j) { const int n = (lane >> 3) + 8 * j; const LAS float* s = scr + (8 * c) * 33 + n;
        v4u o; o.x = pk2(s[0 * 33], s[1 * 33]); o.y = pk2(s[2 * 33], s[3 * 33]); o.z = pk2(s[4 * 33], s[5 * 33]); o.w = pk2(s[6 * 33], s[7 * 33]);
        *(v4u*)(WT + (size_t)(drow0 + n) * K + k0 + 8 * c) = o; }
    LDS_WAIT(); asm volatile("" ::: "memory");
}
__device__ __forceinline__ void tr_item(const float* W, int ldw, int scol0, bf16* WT, int K, int drow0, int k0, LAS float* scr, int lane, const float* rg = nullptr  ) {
    f32x4 v[2][8];
#pragma unroll
    for (int h = 0; h < 2; ++h)
#pragma unroll
        for (int i = 0; i < 8; ++i) v[h][i] = __builtin_nontemporal_load((const f32x4*)(W + (size_t)(k0 + 8 * i + (lane >> 3)) * ldw + scol0 + 32 * h + 4 * (lane & 7)));
    if (rg) {
#pragma unroll
        for (int i = 0; i < 8; ++i) { const float gk = rg[k0 + 8 * i + (lane >> 3)]; v[0][i] = v[0][i] * gk; v[1][i] = v[1][i] * gk; } }
#pragma unroll
    for (int h = 0; h < 2; ++h) {
#pragma unroll
        for (int i = 0; i < 8; ++i) { LAS float* s = scr + (8 * i + (lane >> 3)) * 33 + 4 * (lane & 7); s[0] = v[h][i][0]; s[1] = v[h][i][1]; s[2] = v[h][i][2]; s[3] = v[h][i][3]; }
        tr_store(scr, WT, K, drow0 + 32 * h, k0, lane);
    }
}
__device__ __forceinline__ void tr_item_fold(const float* A, int lda, int J, const float* ps, const float* Wsrc, int jrow0, int n0, bf16* WT, int k0, LAS float* scr, int lane) {
    float acc[32];
#pragma unroll
    for (int n = 0; n < 32; ++n) acc[n] = 0.f;
    const float* arow = A + (size_t)lane * lda;
    for (int j = 0; j < J; j += 4) {
        const f32x4 a4 = *(const f32x4*)(arow + j);
#pragma unroll
        for (int jj = 0; jj < 4; ++jj) { const float* wr = Wsrc + (size_t)(jrow0 + j + jj) * 1024 + n0; const float a = ps ? a4[jj] * ps[j + jj] : a4[jj];
#pragma unroll
            for (int n = 0; n < 32; ++n) acc[n] += a * wr[n]; }
    }
#pragma unroll
    for (int n = 0; n < 32; ++n) scr[lane * 33 + n] = acc[n];
    tr_store(scr, WT, 1024, n0, k0, lane);
}

template <bool HAS_G, bool HAS_PRE, bool HAS_F, bool HAS_P, bool HIN32, bool HOUT32>
__device__ __forceinline__ void ephase(const void* hin_, const bf16* G, const float* gpost, void* hout_, const float* gpre, float* RS  , const f32x4* wf  , const float* bfg, float* LF,
                                       const float* psrc, bf16* pbf, int gw, int NGW, int lane) {
    f32x4 gp[4], gq[4], wfr[16];
#pragma unroll
    for (int j = 0; j < 4; ++j) { if (HAS_G) gp[j] = *(const f32x4*)(gpost + 4 * lane + 256 * j); if (HAS_PRE) gq[j] = *(const f32x4*)(gpre + 4 * lane + 256 * j); }
    if (HAS_F) {
#pragma unroll
        for (int j = 0; j < 4; ++j)
#pragma unroll
            for (int e = 0; e < 4; ++e) wfr[4 * j + e] = wf[(size_t)(4 * lane + 256 * j + e) * (DIN / 4)];
    }
    f32x4 h32[2][4]; v2u hbr[2][4], gbr[2][4]; f32x4 pvr[2];
#define E_LOAD(b_, mm_) do { const size_t q_ = (size_t)(mm_); _Pragma("unroll") for (int j = 0; j < 4; ++j) { \
        if (HIN32) h32[b_][j] = __builtin_nontemporal_load((const f32x4*)((const float*)hin_ + q_ * DM + 4 * lane + 256 * j)); else hbr[b_][j] = *(const v2u*)((const bf16*)hin_ + q_ * DM + 4 * lane + 256 * j); \
        if (HAS_G) gbr[b_][j] = *(const v2u*)(G + q_ * DM + 4 * lane + 256 * j); } \
        if (HAS_P) pvr[b_] = *(const f32x4*)(psrc + q_ * DPLE + 4 * lane); } while (0)
    E_LOAD(0, gw); E_LOAD(1, gw + NGW);
    for (int m0 = gw; m0 < M; m0 += 2 * NGW) {
#pragma unroll
      for (int u = 0; u < 2; ++u) { const int m = m0 + u * NGW;
        const size_t mm = (size_t)m;
        f32x4 v[4], g[4]; const f32x4 pv = pvr[u];
#pragma unroll
        for (int j = 0; j < 4; ++j) { if (HIN32) v[j] = h32[u][j]; else v[j] = (f32x4){bflo(hbr[u][j].x), bfhi(hbr[u][j].x), bflo(hbr[u][j].y), bfhi(hbr[u][j].y)};
            if (HAS_G) g[j] = (f32x4){bflo(gbr[u][j].x), bfhi(gbr[u][j].x), bflo(gbr[u][j].y), bfhi(gbr[u][j].y)}; }
        if (m + 2 * NGW < M) E_LOAD(u, m + 2 * NGW);
        if (HAS_G) {
            float ss = 0.f;
#pragma unroll
            for (int j = 0; j < 4; ++j) ss += (g[j][0] * g[j][0] + g[j][1] * g[j][1]) + (g[j][2] * g[j][2] + g[j][3] * g[j][3]);
            const float r = __builtin_amdgcn_rsqf(wave_sum(ss) * (1.f / DM) + EPS)    ;
#pragma unroll
            for (int j = 0; j < 4; ++j) { v[j] = v[j] + g[j] * r * gp[j];
                if (HOUT32) __builtin_nontemporal_store(v[j], (f32x4*)((float*)hout_ + mm * DM + 4 * lane + 256 * j));
                else { v2u w; w.x = pk2(v[j][0], v[j][1]); w.y = pk2(v[j][2], v[j][3]); *(v2u*)((bf16*)hout_ + mm * DM + 4 * lane + 256 * j) = w; } }
        }
        if (!HAS_G && hout_) {
#pragma unroll
            for (int j = 0; j < 4; ++j) { v2u w; w.x = pk2(v[j][0], v[j][1]); w.y = pk2(v[j][2], v[j][3]); *(v2u*)((bf16*)hout_ + mm * DM + 4 * lane + 256 * j) = w; } }
        if (HAS_PRE) {
            float ss = 0.f;
#pragma unroll
            for (int j = 0; j < 4; ++j) ss += (v[j][0] * v[j][0] + v[j][1] * v[j][1]) + (v[j][2] * v[j][2] + v[j][3] * v[j][3]);
            const float r = __builtin_amdgcn_rsqf(wave_sum(ss) * (1.f / DM) + EPS)    ;
            if (lane == 0) RS[mm] = r;
            if (HAS_F) {
                float d0 = 0.f, d1 = 0.f, d2 = 0.f, d3 = 0.f;
#pragma unroll
                for (int j = 0; j < 4; ++j) { const f32x4 y = v[j] * r * gq[j];
#pragma unroll
                    for (int e = 0; e < 4; ++e) { const f32x4 wv = wfr[4 * j + e]; d0 += y[e] * wv[0]; d1 += y[e] * wv[1]; d2 += y[e] * wv[2]; d3 += y[e] * wv[3]; } }
                d0 = wave_sum(d0); d1 = wave_sum(d1); d2 = wave_sum(d2); d3 = wave_sum(d3);
                if (lane < 4) { float x = (lane == 0 ? d0 : lane == 1 ? d1 : lane == 2 ? d2 : d3) + bfg[lane];
                    LF[mm * 4 + lane] = fminf(x, 0.f) - log1pf(__expf(-fabsf(x))); }
            }
        }
        if (HAS_P) { v2u w; w.x = pk2(pv[0], pv[1]); w.y = pk2(pv[2], pv[3]); *(v2u*)(pbf + mm * DPLE + 4 * lane) = w; }
      }
    }
#undef E_LOAD
}

__device__ __forceinline__ void scan_block(LAS unsigned char* ldsb, const float* LF, float* CB, int bh, int tid, int lane, int wave) {
    const int b = bh >> 2, h = bh & 3; LAS double* wsum = (LAS double*)ldsb;
    float vals[16]; double s = 0.0;
#pragma unroll
    for (int i = 0; i < 16; ++i) { vals[i] = LF[((size_t)b * SEQ + tid * 16 + i) * 4 + h]; s += (double)vals[i]; }
    double inc = s;
#pragma unroll
    for (int o = 1; o < 64; o <<= 1) { const double t = __shfl_up(inc, o); if (lane >= o) inc += t; }
    if (lane == 63) wsum[wave] = inc;
    __syncthreads();
    double run = inc - s;
    for (int w = 0; w < wave; ++w) run += wsum[w];
#pragma unroll
    for (int i = 0; i < 16; ++i) { run += (double)vals[i]; CB[(size_t)bh * SEQ + tid * 16 + i] = (float)(run * 1.4426950408889634); }
    __syncthreads();
}

__device__ __forceinline__ void thin_tile(LAS unsigned char* ldsb, int tile, const bf16* Z, bf16* MC, const float* wdw, const float* lng, const float* lnb, const float* wsc, int tid, int lane, int wave) {
    const int b = tile >> 7, t0 = (tile & 127) * 64; const size_t rowbase = (size_t)b * SEQ;
    LAS float* U = (LAS float*)ldsb;
    {
        v2u ra[12], rg[12];
#pragma unroll
        for (int it_ = 0; it_ < 12; ++it_) { const int idx = tid + 512 * it_; const int r = idx >> 6, q4 = idx & 63, t = t0 - 30 + r;
            ra[it_] = (v2u){0u, 0u}; rg[it_] = (v2u){0u, 0u};
            if (idx < 94 * 64 && t >= 0) { const bf16* zp = Z + (rowbase + t) * ZP + 4 * q4; ra[it_] = *(const v2u*)zp; rg[it_] = *(const v2u*)(zp + 256); } }
#pragma unroll
        for (int it_ = 0; it_ < 12; ++it_) { const int idx = tid + 512 * it_; const int r = idx >> 6, q4 = idx & 63;
            if (idx < 94 * 64) { const v2u a = ra[it_], g = rg[it_]; f32x4 u;
                u[0] = bflo(a.x) * sigm(bflo(g.x)); u[1] = bfhi(a.x) * sigm(bfhi(g.x)); u[2] = bflo(a.y) * sigm(bflo(g.y)); u[3] = bfhi(a.y) * sigm(bfhi(g.y));
                *(LAS f32x4*)(U + r * 256 + 4 * q4) = u; } }
    }
    __syncthreads();
    const int c = tid & 255, half = tid >> 8;
    {
        typedef float f32x2c __attribute__((ext_vector_type(2)));
        float w[31]; f32x2c wp[32], acc2[16];
#pragma unroll
        for (int k = 0; k < 31; ++k) w[k] = wdw[k * 256 + c];
#pragma unroll
        for (int k = 0; k < 32; ++k) wp[k] = (f32x2c){k < 31 ? w[k] : 0.f, k >= 1 ? w[k - 1] : 0.f};
#pragma unroll
        for (int blk = 0; blk < 4; ++blk) {
#pragma unroll
            for (int pp = 0; pp < 4; ++pp) acc2[blk * 4 + pp] = (f32x2c){0.f, 0.f};
#pragma unroll
            for (int j = 0; j < 38; ++j) { const float x = U[(half * 32 + blk * 8 + j) * 256 + c]; const f32x2c xx = {x, x};
#pragma unroll
                for (int pp = 0; pp < 4; ++pp) { const int k = j - 2 * pp; if (k >= 0 && k <= 31) acc2[blk * 4 + pp] += wp[k] * xx; } }
        }
        __syncthreads();
#pragma unroll
        for (int i = 0; i < 16; ++i) { U[(half * 32 + 2 * i) * 256 + c] = acc2[i][0]; U[(half * 32 + 2 * i + 1) * 256 + c] = acc2[i][1]; }
    }
    __syncthreads();
    {
        const f32x4 g4 = *(const f32x4*)(lng + 4 * lane), b4 = *(const f32x4*)(lnb + 4 * lane);
#pragma unroll 2
        for (int i = 0; i < 8; ++i) { const int tok = wave * 8 + i; const f32x4 x = *(const LAS f32x4*)(U + tok * 256 + 4 * lane);
            const float mean = wave_sum((x[0] + x[1]) + (x[2] + x[3])) * (1.f / 256.f); const f32x4 d = x - mean;
            const float var = wave_sum((d[0] * d[0] + d[1] * d[1]) + (d[2] * d[2] + d[3] * d[3])) * (1.f / 256.f); const float rstd = __builtin_amdgcn_rsqf(var + EPS);
            f32x4 y = d * rstd * g4 + b4; y[0] *= sigm(y[0]); y[1] *= sigm(y[1]); y[2] *= sigm(y[2]); y[3] *= sigm(y[3]);
            v2u o; o.x = pk2(y[0], y[1]); o.y = pk2(y[2], y[3]); *(v2u*)(MC + (rowbase + t0 + tok) * DM + 4 * lane) = o; }
    }
    __syncthreads();
    const int ts = t0 + half * 32;
    {
        const float w0 = wsc[c], w1 = wsc[256 + c], w2 = wsc[512 + c];
        float gm2 = 0.f, gm1 = 0.f;
        if (ts >= 2) { const bf16* zp = Z + (rowbase + ts - 2) * ZP; gm2 = bf1(zp[1792 + c]) * bf1(zp[1280 + c]); zp += ZP; gm1 = bf1(zp[1792 + c]) * bf1(zp[1280 + c]); }
#pragma unroll 1
        for (int t8 = 0; t8 < 32; t8 += 16) { const bf16* zp = Z + (rowbase + ts + t8) * ZP + c; bf16 rh[16], rc[16], rb[16];
#pragma unroll
            for (int i = 0; i < 16; ++i) { rh[i] = zp[i * ZP + 1280]; rc[i] = zp[i * ZP + 1792]; rb[i] = zp[i * ZP + 1536]; }
#pragma unroll
            for (int i = 0; i < 16; ++i) { const float g = bf1(rc[i]) * bf1(rh[i]); const float y = bf1(rb[i]) * (w0 * gm2 + w1 * gm1 + w2 * g);
                MC[(rowbase + ts + t8 + i) * DM + 512 + c] = (bf16)f2bf(y); gm2 = gm1; gm1 = g; } }
    }
    {
        const int grp = c >> 6, wi = 2 << grp; const float rinv = 1.0f / (float)wi;
        float vm1 = 0.f, s2c[2] = {0.f, 0.f}, s4c[4], s8c[8];
#pragma unroll
        for (int i = 0; i < 4; ++i) s4c[i] = 0.f;
#pragma unroll
        for (int i = 0; i < 8; ++i) s8c[i] = 0.f;
#pragma unroll 1
        for (int t16 = -16; t16 < 32; t16 += 24) { bf16 rv[24];
#pragma unroll
            for (int i = 0; i < 24; ++i) { const int t = ts + t16 + i; rv[i] = Z[(rowbase + (t >= 0 ? t : 0)) * ZP + 2048 + c]; }
#pragma unroll
            for (int i = 0; i < 24; ++i) { const int tt = t16 + i, t = ts + tt; const float v = t >= 0 ? bf1(rv[i]) : 0.f;
                const float s2 = v + vm1, s4 = s2 + s2c[i & 1], s8 = s4 + s4c[i & 3], s16 = s8 + s8c[i & 7];
                s2c[i & 1] = s2; s4c[i & 3] = s4; s8c[i & 7] = s8; vm1 = v;
                if (tt >= 0) { const float sw = grp == 0 ? s2 : grp == 1 ? s4 : grp == 2 ? s8 : s16; const float ri = (t + 1 >= wi) ? rinv : __builtin_amdgcn_rcpf((float)(t + 1));
                    MC[(rowbase + t) * DM + 768 + c] = (bf16)f2bf(sw * ri - v); } } }
    }
}

#define XB_TMO      128
#define XB_XCNT(j)  (256  + 64 * (j))
#define XB_XSUB(j)  (1280 + 64 * (j))
#define XB_XGEN(j)  (2304 + 64 * (j))
#define XB_TOP      3328
#define XB_TOPGEN   3392
#define XCD_BAR_WORDS 3456
#define XB_SPIN_CAP (1u << 18)

__device__ __forceinline__ unsigned xb_ld(unsigned* p)              { return __hip_atomic_load(p, __ATOMIC_RELAXED, __HIP_MEMORY_SCOPE_AGENT); }
__device__ __forceinline__ unsigned xb_add(unsigned* p, unsigned v) { return __hip_atomic_fetch_add(p, v, __ATOMIC_RELAXED, __HIP_MEMORY_SCOPE_AGENT); }
__device__ __forceinline__ unsigned xb_xcc_id() { return (unsigned)__builtin_amdgcn_s_getreg((3 << 11) | 20) & 0xFu; }
#define XB_SPIN(cond, bar) do { unsigned _sp = 0; while (cond) { __builtin_amdgcn_s_sleep(1); \
    if ((++_sp & 255u) == 0u) { if (xb_ld(&(bar)[XB_TMO])) break; if (_sp > XB_SPIN_CAP) { atomicAdd(&(bar)[XB_TMO], 1u); break; } } } } while (0)

struct XcdBarrier {
    unsigned* bar; unsigned x;
    volatile LAS unsigned* st;
};

__device__ __forceinline__ XcdBarrier xcd_barrier_post(unsigned* bar, volatile LAS unsigned* st) {
    XcdBarrier b; b.bar = bar; b.x = xb_xcc_id(); b.st = st;
    if (threadIdx.x == 0) (void)xb_add(&bar[XB_XCNT(b.x)], 1u);
    return b;
}
__device__ __forceinline__ void xcd_barrier_complete(unsigned* bar, unsigned x, unsigned& nloc, unsigned& nx) {
    const unsigned G = gridDim.x * gridDim.y * gridDim.z;
    unsigned sum, cnt, mine, sp = 0u;
    for (;;) {
        sum = 0u; cnt = 0u; mine = 0u;
#pragma unroll
        for (unsigned j = 0; j < 16; ++j) { const unsigned c = xb_ld(&bar[XB_XCNT(j)]); sum += c; cnt += (c > 0u) ? 1u : 0u; mine = (j == x) ? c : mine; }
        if (sum == G) break;
        __builtin_amdgcn_s_sleep(1);
        if ((++sp & 255u) == 0u) { if (xb_ld(&bar[XB_TMO])) break; if (sp > XB_SPIN_CAP) { atomicAdd(&bar[XB_TMO], 1u); break; } }
    }
    nloc = mine > 0u ? mine : 1u; nx = cnt > 0u ? cnt : 1u;
}

__device__ __forceinline__ void xcd_barrier(const XcdBarrier& b, int tid_in) {
    asm volatile("s_waitcnt vmcnt(0)" ::: "memory");
    __syncthreads();
    if (tid_in == 0) {
        unsigned* bar = b.bar;
        __builtin_amdgcn_s_waitcnt(0);
        unsigned nloc = b.st[0], nx = b.st[1];
        if (nloc == 0u) { xcd_barrier_complete(bar, b.x, nloc, nx); b.st[0] = nloc; b.st[1] = nx; }
        const unsigned old = xb_add(&bar[XB_XSUB(b.x)], 1u);
        const unsigned gen = old / nloc;
        if (old + 1u == (gen + 1u) * nloc) {
            __builtin_amdgcn_fence(__ATOMIC_RELEASE, "agent");
            asm volatile("s_waitcnt vmcnt(0)" ::: "memory");
            const unsigned og = xb_add(&bar[XB_TOP], 1u);
            const unsigned tg = og / nx;
            if (og + 1u == (tg + 1u) * nx) xb_add(&bar[XB_TOPGEN], 1u);
            else XB_SPIN(xb_ld(&bar[XB_TOPGEN]) == tg, bar);
            __builtin_amdgcn_fence(__ATOMIC_ACQUIRE, "agent");
            xb_add(&bar[XB_XGEN(b.x)], 1u);
            asm volatile("s_waitcnt vmcnt(0)" ::: "memory");
        } else {
            XB_SPIN(xb_ld(&bar[XB_XGEN(b.x)]) == gen, bar);
            __builtin_amdgcn_fence(__ATOMIC_ACQUIRE, "agent");
            asm volatile("s_waitcnt vmcnt(0)" ::: "memory");
        }
    }
    __syncthreads();
}

#ifndef MK_SPLIT
#define MK_SPLIT 0
#endif
typedef unsigned char* ws_ptr_t;
struct Args { const float* in[22]; float* out; unsigned char* ws; int ph_lo, ph_hi; };
enum { I_X = 0, I_P, I_GMIXPRE, I_WIN, I_BF, I_WDW, I_LNG, I_LNB, I_WPW, I_WSC, I_WPOOL, I_PSC, I_WOUT, I_GMIXPOST, I_GMLPPRE, I_WUP, I_WDN, I_GMLPPOST, I_GPLEPRE, I_WG, I_WP, I_GPLEPOST };

__global__ void __launch_bounds__(NWAVES * 64, 2) mk_fwd(Args args) {
    extern __shared__ __attribute__((aligned(16))) unsigned char lds[];
    cg::grid_group grid = cg::this_grid();
    LAS unsigned char* ldsb = (LAS unsigned char*)lds;
#define IDS() int tid = threadIdx.x; asm volatile("" : "+v"(tid)); int G = gridDim.x, bx = blockIdx.x; asm volatile("" : "+s"(G), "+s"(bx)); \
    const int vcu = (G % 8 == 0) ? (bx % 8) * (G / 8) + bx / 8 : bx, NGW = G * NWAVES, lane = tid & 63, wave = __builtin_amdgcn_readfirstlane(tid >> 6), gw = vcu * NWAVES + wave; (void)lane; (void)gw; (void)NGW;
    if (threadIdx.x < 64) ((LAS unsigned*)(ldsb + 131072))[threadIdx.x] = 0u;
    __syncthreads();
#define MKBAR() XcdBarrier bar; bar.bar = (unsigned*)(WSP() + WS_BAR); bar.x = xb_xcc_id(); bar.st = (volatile LAS unsigned*)(ldsb + 131072 + 32);
    typedef __attribute__((address_space(4))) const unsigned char* kptr_t; typedef const float* cfp_t; typedef unsigned char* ucp_t;
#define KARG() ({ kptr_t k_ = (kptr_t)__builtin_amdgcn_kernarg_segment_ptr(); asm volatile("" : "+s"(k_)); k_; })
#define INP(i) (*(const __attribute__((address_space(4))) cfp_t*)(KARG() + 8 * (i)))
#define WSP() (*(const __attribute__((address_space(4))) ucp_t*)(KARG() + 184))
#define LF ((float*)(WSP() + WS_LF))
#define CB ((float*)(WSP() + WS_CB))
#define WF ((f32x4*)(WSP() + WS_WF))
#define RS ((float*)(WSP() + WS_RS))
#define HB ((bf16*)(WSP() + WS_XN))
#define GB ((bf16*)(WSP() + WS_G))
#define Z ((bf16*)(WSP() + WS_Z))
#define MC ((bf16*)(WSP() + WS_MC))
#define UP ((bf16*)(WSP() + WS_UP))
#define PROJ ((bf16*)(WSP() + WS_PROJ))
#define PBF ((bf16*)(WSP() + WS_PBF))
#define HOUT ((float*)(*(const __attribute__((address_space(4))) ucp_t*)(KARG() + 176)))
#if MK_SPLIT
    const int lo = *(const __attribute__((address_space(4))) int*)(KARG() + 192), hi = *(const __attribute__((address_space(4))) int*)(KARG() + 196);
#endif
    { (void)xcd_barrier_post((unsigned*)(WSP() + WS_BAR), (volatile LAS unsigned*)(ldsb + 131072 + 32)); }
#if MK_SPLIT
#define IN(k) (lo <= (k) && (k) < hi)
#else
#define IN(k) true
#endif
    if (*(const __attribute__((address_space(4))) int*)(KARG() + 192) < 0) grid.sync();
#define SEAM(k) do { if (IN(k) && IN((k) + 1)) { MKBAR(); xcd_barrier(bar, (int)threadIdx.x); } } while (0)

    if (IN(0)) {
        IDS();
#ifndef NO_PRO
        LAS float* scr = (LAS float*)(ldsb + wave * 16384);
        constexpr int I_IN1 = 16 * 40, I_IN2 = 16 * 32, I_O = 16 * 32, I_UP = 16 * 128, I_DN = 64 * 32, I_G = 16 * 32, I_PP = 4 * 32, I_LAYER = I_IN1 + I_IN2 + I_O + I_UP + I_DN + I_G + I_PP;
        static_assert(I_LAYER - 256 == 6144 && DEPTH * 128 == 512, "prologue deal");
        const int cls = gw & 3, ci = gw >> 2;
        const int pcnt = cls == 0 ? 4 : cls == 1 ? 7 : 8, pbeg = cls == 0 ? ci * 3 : cls == 1 ? 1536 + ci * 6 : 4608 + ci * 2 + (cls - 2), pstep = cls < 2 ? 1 : 1024;
        for (int step = 0; step < 2; ++step) {
        if (((step ^ wave) & 1) == 0) {
        for (int sl = 0; sl < pcnt; ++sl) {
            int l, r;
            if (cls < 2 && sl == 0) { l = ci >> 7; r = (cls == 0 ? 0 : 384) + (ci & 127); }
            else { const int p = pbeg + (cls < 2 ? sl - 1 : sl) * pstep; if (p >= DEPTH * 3072) break; l = p / 3072; const int rr = 2 * (p % 3072); r = rr < 256 ? 128 + rr : rr + 256; }
            unsigned char* wl = WSP() + WS_W + (size_t)l * W_STRIDE;
            if (r < I_O) {
                const int kb = r / 32, nb = r % 32, k0 = 64 * kb; const float* wout = INP(I_WOUT) + (size_t)l * 1024 * 1024;
                if (kb < 4) tr_item_fold(INP(I_WPW) + (size_t)l * 65536 + (size_t)k0 * 256, 256, 256, nullptr, wout, 0, 32 * nb, (bf16*)(wl + WO_O), k0, scr, lane);
                else if (kb >= 12) { const int g = kb - 12; tr_item_fold(INP(I_WPOOL) + (size_t)l * 16384 + (size_t)g * 4096, 64, 64, INP(I_PSC) + l * 256 + 64 * g, wout, 768 + 64 * g, 32 * nb, (bf16*)(wl + WO_O), k0, scr, lane); }
                else tr_item(wout, 1024, 32 * nb, (bf16*)(wl + WO_O), 1024, 32 * nb, k0, scr, lane);
                continue; } r -= I_O;
            if (r < I_IN1) { const int kb = r / 40, nb = r % 40; tr_item(INP(I_WIN) + (size_t)l * 1024 * DIN, DIN, 32 * nb, (bf16*)(wl + WO_IN), 1024, 32 * nb, 64 * kb, scr, lane, INP(I_GMIXPRE) + l * 1024); continue; } r -= I_IN1;
            if (r < I_IN2) { const int kb = r / 32, nb = r % 32; tr_item(INP(I_WIN) + (size_t)l * 1024 * DIN, DIN, 1284 + 32 * nb, (bf16*)(wl + WO_IN), 1024, 1280 + 32 * nb, 64 * kb, scr, lane, INP(I_GMIXPRE) + l * 1024); continue; } r -= I_IN2;
            if (r < I_UP) { const int kb = r / 128, nb = r % 128; tr_item(INP(I_WUP) + (size_t)l * 1024 * FF, FF, 32 * nb, (bf16*)(wl + WO_UP), 1024, 32 * nb, 64 * kb, scr, lane, INP(I_GMLPPRE) + l * 1024); continue; } r -= I_UP;
            if (r < I_DN) { const int kb = r / 32, nb = r % 32; tr_item(INP(I_WDN) + (size_t)l * FF * 1024, 1024, 32 * nb, (bf16*)(wl + WO_DN), FF, 32 * nb, 64 * kb, scr, lane); continue; } r -= I_DN;
            if (r < I_G) { const int kb = r / 32, nb = r % 32; tr_item(INP(I_WG) + (size_t)l * 1024 * 1024, 1024, 32 * nb, (bf16*)(wl + WO_G), 1024, 32 * nb, 64 * kb, scr, lane, INP(I_GPLEPRE) + l * 1024); continue; } r -= I_G;
            { const int kb = r / 32, nb = r % 32; tr_item(INP(I_WP) + (size_t)l * DPLE * 1024, 1024, 32 * nb, (bf16*)(wl + WO_P), DPLE, 32 * nb, 64 * kb, scr, lane); }
        }
        } else
        ephase<false, true, true, false, true, false>(INP(I_X), nullptr, nullptr, HB, INP(I_GMIXPRE), RS, (const f32x4*)(INP(I_WIN) + 1280), INP(I_BF), LF, nullptr, nullptr, gw, NGW, lane);
        }
#endif
        __syncthreads();
    }
    SEAM(0);

#pragma unroll 1
    for (int l = 0; l < DEPTH; ++l) {
        const int pb = 1 + 11 * l;
#define wl (WSP() + WS_W + (size_t)l * W_STRIDE)
        if (IN(pb + 1)) {
            IDS();
            if (bx >= 128 && bx < 144) scan_block(ldsb, LF, CB, bx - 128, tid, lane, wave);
            pg8::Gemm g{HB, (const bf16*)(wl + WO_IN), M, ZP, 1024}; pg8::StaticOrder S; S.init(M, ZP, G, bx);
            pg8::EpiT<2> E{Z, ZP, nullptr, 2, attn_body::C2, (float*)(WSP() + WS_NRM), RS};
#ifndef NO_GEMM1
            pg8::gemm_phase<pg8::EpiT<2>, pg8::StaticOrder, true, true>(ldsb, g, S, E, tid);
#endif
            if (bx >= 128) {
                const float* psrc = INP(I_P) + (size_t)l * M * DPLE; bf16* pdst = PBF; const int w0 = (bx - 128) * NWAVES + wave;
                for (int m = w0; m < M; m += 128 * NWAVES * 4) { f32x4 pv[4];
#pragma unroll
                    for (int i = 0; i < 4; ++i) pv[i] = *(const f32x4*)(psrc + (size_t)(m + i * 128 * NWAVES) * DPLE + 4 * lane);
#pragma unroll
                    for (int i = 0; i < 4; ++i) { v2u w; w.x = pk2(pv[i][0], pv[i][1]); w.y = pk2(pv[i][2], pv[i][3]); *(v2u*)(pdst + (size_t)(m + i * 128 * NWAVES) * DPLE + 4 * lane) = w; } }
            }
        }
        SEAM(pb + 1);
        if (IN(pb + 2)) {
            IDS();
#ifndef NO_THIN
            for (int tile = vcu; tile < M / 64; tile += G)
                thin_tile(ldsb, tile, Z, MC, INP(I_WDW) + (size_t)l * 31 * 256, INP(I_LNG) + l * 256, INP(I_LNB) + l * 256, INP(I_WSC) + l * 768, tid, lane, wave);
#endif
            const attn_body::AttnTensors AT{(const attn_body::bf16*)(Z + 512), (const attn_body::bf16*)(Z + 768), (const attn_body::bf16*)(Z + 1024), (attn_body::bf16*)(MC + 256), CB, (const float*)(WSP() + WS_NRM)};
            const attn_body::StaticOrder S(G, bx);
#ifndef NO_ATTN
            attn_body::attn_phase<attn_body::StaticOrder>((char*)lds, AT, S, tid);
#endif
        }
        SEAM(pb + 2);
        if (IN(pb + 3)) {
            IDS();
            pg8::Gemm g{MC, (const bf16*)(wl + WO_O), M, 1024, 1024}; pg8::StaticOrder S; S.init(M, 1024, G, bx);
            pg8::EpiT<0> E{GB, 1024, nullptr, 0, 1.f, nullptr, nullptr};
#ifndef NO_GEMM2
            pg8::gemm_phase<pg8::EpiT<0>, pg8::StaticOrder, true, true>(ldsb, g, S, E, tid);
#endif
        }
        SEAM(pb + 3);
        if (IN(pb + 4)) { IDS();
            ephase<true, true, false, false, false, false>(HB, GB, INP(I_GMIXPOST) + l * 1024, HB, INP(I_GMLPPRE) + l * 1024, RS, nullptr, nullptr, nullptr, nullptr, nullptr, gw, NGW, lane); }
        SEAM(pb + 4);
        if (IN(pb + 5)) {
            IDS();
            pg8::Gemm g{HB, (const bf16*)(wl + WO_UP), M, FF, 1024}; pg8::StaticOrder S; S.init(M, FF, G, bx);
            pg8::EpiT<1> E{UP, FF, nullptr, 0, 1.f, nullptr, RS};
#ifndef NO_GEMM3
            pg8::gemm_phase<pg8::EpiT<1>, pg8::StaticOrder, true, true>(ldsb, g, S, E, tid);
#endif
        }
        SEAM(pb + 5);
        if (IN(pb + 6)) {
            IDS();
            pg8::Gemm g{UP, (const bf16*)(wl + WO_DN), M, 1024, FF}; pg8::StaticOrder S; S.init(M, 1024, G, bx);
            pg8::EpiT<0> E{GB, 1024, nullptr, 0, 1.f, nullptr, nullptr};
#ifndef NO_GEMM4
            pg8::gemm_phase<pg8::EpiT<0>, pg8::StaticOrder, true, true>(ldsb, g, S, E, tid);
#endif
        }
        SEAM(pb + 6);
        if (IN(pb + 7)) { IDS(); ephase<true, true, false, false, false, false>(HB, GB, INP(I_GMLPPOST) + l * 1024, HB, INP(I_GPLEPRE) + l * 1024, RS, nullptr, nullptr, nullptr, nullptr, nullptr, gw, NGW, lane); }
        SEAM(pb + 7);
        if (IN(pb + 8)) {
            IDS();
            pg8::Gemm g{PBF, (const bf16*)(wl + WO_P), M, 1024, DPLE}; pg8::StaticOrder S; S.init(M, 1024, G, bx);
            pg8::EpiT<0> E{PROJ, 1024, nullptr, 0, 1.f, nullptr, nullptr};
#ifndef NO_GEMM5
            pg8::gemm_phase<pg8::EpiT<0>, pg8::StaticOrder, true, true>(ldsb, g, S, E, tid);
#endif
        }
        if (IN(pb + 9)) {
            IDS();
            asm volatile("s_waitcnt vmcnt(0)" ::: "memory"); __builtin_amdgcn_fence(__ATOMIC_ACQUIRE, "agent");
            pg8::Gemm g{HB, (const bf16*)(wl + WO_G), M, 1024, 1024}; pg8::StaticOrder S; S.init(M, 1024, G, bx);
            pg8::EpiT<3> E{GB, 1024, PROJ, 0, 1.f, nullptr, RS};
#ifndef NO_GEMM6
            pg8::gemm_phase<pg8::EpiT<3>, pg8::StaticOrder, true, true>(ldsb, g, S, E, tid);
#endif
        }
        SEAM(pb + 9);
        if (IN(pb + 10)) {
            IDS();
            if (l + 1 < DEPTH) ephase<true, true, true, false, false, false>(HB, GB, INP(I_GPLEPOST) + l * 1024, HB, INP(I_GMIXPRE) + (l + 1) * 1024, RS, (const f32x4*)(INP(I_WIN) + (size_t)(l + 1) * 1024 * DIN + 1280), INP(I_BF) + (l + 1) * 4, LF, nullptr, nullptr, gw, NGW, lane);
            else ephase<true, false, false, false, false, true>(HB, GB, INP(I_GPLEPOST) + l * 1024, HOUT, nullptr, nullptr, nullptr, nullptr, nullptr, nullptr, nullptr, gw, NGW, lane);
        }
        SEAM(pb + 10);
    }
#undef IN
#undef SEAM
#undef KARG
#undef INP
#undef WSP
#undef LF
#undef CB
#undef WF
#undef RS
#undef GB
#undef Z
#undef MC
#undef UP
#undef PROJ
#undef PBF
#undef HOUT
#undef HB
#undef wl
#undef IDS
#undef MKBAR
}
constexpr int N_PHASES = 1 + 11 * DEPTH;

extern "C" void kernel_launch(void* const* d_in, const int* in_sizes, int n_in, void* d_out, int out_size, void* d_ws, size_t ws_size, hipStream_t stream) {
    static int grid = 0;
    if (grid == 0) {
        if (n_in != 22 || out_size != M * DM || ws_size < WS_END) { fprintf(stderr, "kernel_launch: unexpected problem (n_in %d, out %d, ws %zu); nothing launched\n", n_in, out_size, ws_size); grid = -1; return; }
        int dev = 0, cus = 0;
        if (hipGetDevice(&dev) != hipSuccess || hipDeviceGetAttribute(&cus, hipDeviceAttributeMultiprocessorCount, dev) != hipSuccess) { grid = -1; return; }
        if (hipFuncSetAttribute((const void*)mk_fwd, hipFuncAttributeMaxDynamicSharedMemorySize, LDS_BYTES) != hipSuccess) { fprintf(stderr, "kernel_launch: hipFuncSetAttribute failed\n"); grid = -1; return; }
        int per_cu = 0;
        if (hipOccupancyMaxActiveBlocksPerMultiprocessor(&per_cu, (const void*)mk_fwd, NWAVES * 64, LDS_BYTES) != hipSuccess || per_cu < 1) fprintf(stderr, "kernel_launch: occupancy query says %d\n", per_cu);
        (void)hipGetLastError();
        grid = cus;
        if (grid != 256) fprintf(stderr, "kernel_launch: %d CUs; this kernel is dealt for 256\n", grid);
    }
    if (grid < 0) return;
    if (hipMemsetAsync(d_ws, 0, WS_CTL_BYTES, stream) != hipSuccess) { fprintf(stderr, "kernel_launch: memset failed\n"); return; }
    Args a{};
    for (int i = 0; i < 22; ++i) a.in[i] = (const float*)d_in[i];
    a.out = (float*)d_out; a.ws = (unsigned char*)d_ws;
#if MK_SPLIT
    for (int p = 0; p < N_PHASES; ++p) { a.ph_lo = p; a.ph_hi = p + 1; hipLaunchKernelGGL(mk_fwd, dim3(grid), dim3(NWAVES * 64), LDS_BYTES, stream, a); }
#else
    a.ph_lo = 0; a.ph_hi = N_PHASES;
    void* kargs[] = {&a};
    const hipError_t e = hipLaunchCooperativeKernel((const void*)mk_fwd, dim3(grid), dim3(NWAVES * 64), kargs, LDS_BYTES, stream);
    if (e != hipSuccess) fprintf(stderr, "kernel_launch: cooperative launch failed: %s\n", hipGetErrorString(e));
#endif
}
```
